# Optimizing an MI355X kernel written in HIP

```python
import jax, jax.numpy as jnp
from jax import lax
import numpy as np

D_MODEL = 1024
BATCH = 8
SEQ = 8192
DEPTH = 4
DEC_BATCH = 8
DEC_SEQ = 32
PAST_LEN = 1024

CHUNK = 64
D_RWKV = D_MODEL
RWKV_HEAD_DIM = 64
N_RWKV_HEADS = D_RWKV // RWKV_HEAD_DIM
DECAY_LORA = 64
ICLR_LORA = 64
GATE_LORA = 128
RWKV_COLS = 3 * D_RWKV + DECAY_LORA + ICLR_LORA + GATE_LORA
RWKV_SPLITS = (D_RWKV, 2 * D_RWKV, 3 * D_RWKV, 3 * D_RWKV + DECAY_LORA, 3 * D_RWKV + DECAY_LORA + ICLR_LORA)
GMLP_WIDTH = D_MODEL
GMLP_CHUNK = 128
GMLP_GROUP_CH = 128
GMLP_GROUPS = GMLP_WIDTH // GMLP_GROUP_CH
N_MEM = 256
X_HEADS = 4
X_HEAD_DIM = D_MODEL // X_HEADS
D_X = X_HEADS * X_HEAD_DIM
N_BRANCH = 3
BRANCH_WIDTH = D_MODEL
COL_GMLP = RWKV_COLS
COL_Q = COL_GMLP + 2 * GMLP_WIDTH
COL_GATE = COL_Q + D_X
IN_COLS = COL_GATE + N_BRANCH * D_MODEL
D_FF = 4 * D_MODEL
RMS_EPS = 1e-6
LN_EPS = 1e-5
GN_EPS = 64e-5

kernel_name = 'hybrid_rwkv7_sgu_memxattn_stream_step'


def _rmsnorm(x, g):
    xf = x.astype(jnp.float32)
    y = xf * lax.rsqrt(jnp.mean(xf * xf, axis=-1, keepdims=True) + RMS_EPS)
    return (y * g.astype(jnp.float32)).astype(x.dtype)


def _layernorm(x, g, b, eps):
    xf = x.astype(jnp.float32)
    xc = xf - jnp.mean(xf, axis=-1, keepdims=True)
    var = jnp.mean(xc * xc, axis=-1, keepdims=True)
    y = xc * lax.rsqrt(var + eps) * g.astype(jnp.float32) + b.astype(jnp.float32)
    return y.astype(x.dtype)


def _rwkv7_recurrence(r, decay, k, v, a_vec, b_vec, s0):
    def step(s, inp):
        r_t, w_t, k_t, v_t, a_t, b_t = inp
        sa = jnp.einsum('bhvk,bhk->bhv', s, a_t)
        s = s * w_t[:, :, None, :] + sa[..., None] * b_t[:, :, None, :] + v_t[..., None] * k_t[:, :, None, :]
        y = jnp.einsum('bhvk,bhk->bhv', s, r_t)
        return s, y
    xs = tuple(jnp.swapaxes(t, 0, 1) for t in (r, decay, k, v, a_vec, b_vec))
    s_final, ys = lax.scan(step, s0, xs)
    return jnp.swapaxes(ys, 0, 1), s_final


def _rwkv7_mixer(cols, prev_row, wkv0, mu, w0, w2, a0, a2, g2, k_k, k_a, r_k, lnx_g, lnx_b):
    B, T, _ = cols.shape
    dt = cols.dtype
    f32 = jnp.float32
    H, N = N_RWKV_HEADS, RWKV_HEAD_DIM
    shifted = jnp.concatenate([prev_row.astype(dt), cols[:, :-1]], axis=1)
    mixed = cols + (shifted - cols) * mu.astype(dt)
    r, k, v, wl, al, gl = jnp.split(mixed, RWKV_SPLITS, axis=-1)
    z = (w0 + jnp.tanh(wl) @ w2).astype(f32)
    decay = jnp.exp(-jnp.exp(-jax.nn.softplus(-z) - 0.5))
    a = jax.nn.sigmoid((a0 + al @ a2).astype(f32))
    g = jax.nn.sigmoid(gl) @ g2
    heads = lambda t: t.astype(f32).reshape(B, T, H, N)
    r_h, k_h, v_h, a_h, decay_h = heads(r), heads(k), heads(v), heads(a), heads(decay)
    kk = k_h * k_k.astype(f32).reshape(H, N)
    kk = kk * lax.rsqrt(jnp.maximum(jnp.sum(kk * kk, axis=-1, keepdims=True), 1e-24))
    k_h = k_h * (1.0 + (a_h - 1.0) * k_a.astype(f32).reshape(H, N))
    y, wkv = _rwkv7_recurrence(r_h, decay_h, k_h, v_h, -kk, kk * a_h, wkv0.astype(f32))
    y = _layernorm(y, lnx_g.reshape(H, N), lnx_b.reshape(H, N), GN_EPS)
    y = y + jnp.sum(r_h * k_h * r_k.astype(f32), axis=-1, keepdims=True) * v_h
    y = y.reshape(B, T, D_RWKV).astype(dt) * g
    return y, cols[:, -1:], wkv


def _sgu_mixer(cols, ln_g, ln_b, w_s, b_s):
    B, T, _ = cols.shape
    z = jax.nn.gelu(cols)
    u, v = jnp.split(z, 2, axis=-1)
    v = _layernorm(v, ln_g, ln_b, LN_EPS)
    pad = (-T) % GMLP_CHUNK
    n_chunks = (T + pad) // GMLP_CHUNK
    vc = jnp.pad(v, ((0, 0), (0, pad), (0, 0))).reshape(B, n_chunks, GMLP_CHUNK, GMLP_GROUPS, GMLP_GROUP_CH)
    mask = jnp.tril(jnp.ones((GMLP_CHUNK, GMLP_CHUNK), dtype=bool))
    ws = jnp.where(mask, w_s, jnp.zeros((), w_s.dtype)).astype(v.dtype)
    sv = jnp.einsum('gij,bnjgc->bnigc', ws, vc) + b_s.T.astype(v.dtype)[None, None, :, :, None]
    sv = sv.reshape(B, n_chunks * GMLP_CHUNK, GMLP_WIDTH)[:, :T]
    return u * sv, v


def _memory_kv(mem, g, w_kv):
    B = mem.shape[0]
    kv = _rmsnorm(mem, g) @ w_kv
    k, v = jnp.split(kv, 2, axis=-1)
    return k.reshape(B, N_MEM, X_HEADS, X_HEAD_DIM), v.reshape(B, N_MEM, X_HEADS, X_HEAD_DIM)


def _memory_attention(q_cols, mem_k, mem_v):
    B, T, _ = q_cols.shape
    q = q_cols.reshape(B, T, X_HEADS, X_HEAD_DIM)
    s = jnp.einsum('bthd,bmhd->bhtm', q, mem_k.astype(q.dtype)).astype(jnp.float32) * (X_HEAD_DIM ** -0.5)
    p = jax.nn.softmax(s, axis=-1).astype(q.dtype)
    o = jnp.einsum('bhtm,bmhd->bthd', p, mem_v.astype(q.dtype))
    return o.reshape(B, T, D_X)


def _layer(x, mem_k, mem_v, prev_row, wkv0, lp):
    h = _rmsnorm(x, lp['norm_mix_g'])
    w_in = lp['w_in']
    y_a, new_row, wkv = _rwkv7_mixer(h @ w_in[:, :COL_GMLP], prev_row, wkv0, lp['rwkv_mu'], lp['rwkv_w0'],
                                     lp['rwkv_w2'], lp['rwkv_a0'], lp['rwkv_a2'], lp['rwkv_g2'], lp['rwkv_k_k'],
                                     lp['rwkv_k_a'], lp['rwkv_r_k'], lp['rwkv_lnx_g'], lp['rwkv_lnx_b'])
    y_b, v_rows = _sgu_mixer(h @ w_in[:, COL_GMLP:COL_Q], lp['sgu_ln_g'], lp['sgu_ln_b'], lp['sgu_w_s'], lp['sgu_b_s'])
    y_c = _memory_attention(h @ w_in[:, COL_Q:COL_GATE], mem_k, mem_v)
    gate = jax.nn.sigmoid((h @ w_in[:, COL_GATE:]).astype(jnp.float32)).astype(x.dtype)
    w_b = lp['w_branch']
    merged = (gate[..., :D_MODEL] * (y_a @ w_b[0])
              + gate[..., D_MODEL:2 * D_MODEL] * (y_b @ w_b[1])
              + gate[..., 2 * D_MODEL:] * (y_c @ w_b[2]))
    x = x + merged @ lp['w_out']
    up = _rmsnorm(x, lp['norm_ffn_g']) @ lp['w_ffn_up']
    x = x + jnp.square(jax.nn.relu(up)) @ lp['w_ffn_down']
    return x, new_row, wkv, v_rows


def setup_inputs(seed: int = 0) -> dict:
    key = jax.random.key(seed)
    ks = iter(jax.random.split(key, 40))
    f32 = jnp.float32
    nrm = lambda shape, scale: scale * jax.random.normal(next(ks), shape, f32)
    uni = lambda shape: jax.random.uniform(next(ks), shape, f32)
    H, N = N_RWKV_HEADS, RWKV_HEAD_DIM
    return {
        'x_prompt': nrm((BATCH, SEQ, D_MODEL), 1.0),
        'x_sample': nrm((DEC_BATCH, DEC_SEQ, D_MODEL), 1.0),
        'cache_mem_k': nrm((DEPTH, DEC_BATCH, N_MEM, X_HEADS, X_HEAD_DIM), 1.0),
        'cache_mem_v': nrm((DEPTH, DEC_BATCH, N_MEM, X_HEADS, X_HEAD_DIM), 1.0),
        'state_wkv': nrm((DEPTH, DEC_BATCH, H, N, N), 0.3),
        'state_shift': nrm((DEPTH, DEC_BATCH, 1, RWKV_COLS), 1.0),
        'mem_prompt': nrm((BATCH, N_MEM, D_MODEL), 1.0),
        'norm_mix_g': 1.0 + nrm((DEPTH, D_MODEL), 0.01),
        'norm_mem_g': 1.0 + nrm((DEPTH, D_MODEL), 0.01),
        'norm_ffn_g': 1.0 + nrm((DEPTH, D_MODEL), 0.01),
        'norm_final_g': 1.0 + nrm((D_MODEL,), 0.01),
        'w_in': nrm((DEPTH, D_MODEL, IN_COLS), D_MODEL ** -0.5),
        'w_mem_kv': nrm((DEPTH, D_MODEL, 2 * D_X), D_MODEL ** -0.5),
        'rwkv_mu': uni((DEPTH, RWKV_COLS)),
        'rwkv_w0': -7.0 + 5.0 * uni((DEPTH, D_RWKV)),
        'rwkv_w2': nrm((DEPTH, DECAY_LORA, D_RWKV), 0.1),
        'rwkv_a0': nrm((DEPTH, D_RWKV), 0.1),
        'rwkv_a2': nrm((DEPTH, ICLR_LORA, D_RWKV), 0.1),
        'rwkv_g2': nrm((DEPTH, GATE_LORA, D_RWKV), GATE_LORA ** -0.5),
        'rwkv_k_k': 0.85 + nrm((DEPTH, D_RWKV), 0.05),
        'rwkv_k_a': 1.0 + nrm((DEPTH, D_RWKV), 0.05),
        'rwkv_r_k': nrm((DEPTH, H, N), 0.1),
        'rwkv_lnx_g': 1.0 + nrm((DEPTH, D_RWKV), 0.01),
        'rwkv_lnx_b': nrm((DEPTH, D_RWKV), 0.01),
        'sgu_ln_g': 1.0 + nrm((DEPTH, GMLP_WIDTH), 0.01),
        'sgu_ln_b': nrm((DEPTH, GMLP_WIDTH), 0.01),
        'sgu_w_s': nrm((DEPTH, GMLP_GROUPS, GMLP_CHUNK, GMLP_CHUNK), GMLP_CHUNK ** -0.5),
        'sgu_b_s': 1.0 + nrm((DEPTH, GMLP_GROUPS, GMLP_CHUNK), 0.01),
        'w_branch': nrm((DEPTH, N_BRANCH, BRANCH_WIDTH, D_MODEL), BRANCH_WIDTH ** -0.5),
        'w_out': nrm((DEPTH, D_MODEL, D_MODEL), D_MODEL ** -0.5),
        'w_ffn_up': nrm((DEPTH, D_MODEL, D_FF), D_MODEL ** -0.5),
        'w_ffn_down': nrm((DEPTH, D_FF, D_MODEL), D_FF ** -0.5),
    }


def reference(x_prompt, x_sample, cache_mem_k, cache_mem_v, state_wkv, state_shift, mem_prompt,
              norm_mix_g, norm_mem_g, norm_ffn_g, norm_final_g, w_in, w_mem_kv,
              rwkv_mu, rwkv_w0, rwkv_w2, rwkv_a0, rwkv_a2, rwkv_g2, rwkv_k_k, rwkv_k_a, rwkv_r_k,
              rwkv_lnx_g, rwkv_lnx_b, sgu_ln_g, sgu_ln_b, sgu_w_s, sgu_b_s,
              w_branch, w_out, w_ffn_up, w_ffn_down):
    b_p = x_prompt.shape[0]
    H, N = N_RWKV_HEADS, RWKV_HEAD_DIM
    prompt_row0 = jnp.zeros((b_p, 1, RWKV_COLS), x_prompt.dtype)
    prompt_wkv0 = jnp.zeros((b_p, H, N, N), jnp.float32)
    xp, xs = x_prompt, x_sample
    mk_p, mv_p, wkv_p, row_p, wkv_s, row_s, v_s = [], [], [], [], [], [], []
    for l in range(DEPTH):
        lp = {
            'norm_mix_g': norm_mix_g[l], 'w_in': w_in[l],
            'rwkv_mu': rwkv_mu[l], 'rwkv_w0': rwkv_w0[l], 'rwkv_w2': rwkv_w2[l],
            'rwkv_a0': rwkv_a0[l], 'rwkv_a2': rwkv_a2[l], 'rwkv_g2': rwkv_g2[l],
            'rwkv_k_k': rwkv_k_k[l], 'rwkv_k_a': rwkv_k_a[l], 'rwkv_r_k': rwkv_r_k[l],
            'rwkv_lnx_g': rwkv_lnx_g[l], 'rwkv_lnx_b': rwkv_lnx_b[l],
            'sgu_ln_g': sgu_ln_g[l], 'sgu_ln_b': sgu_ln_b[l], 'sgu_w_s': sgu_w_s[l], 'sgu_b_s': sgu_b_s[l],
            'w_branch': w_branch[l], 'w_out': w_out[l],
            'norm_ffn_g': norm_ffn_g[l], 'w_ffn_up': w_ffn_up[l], 'w_ffn_down': w_ffn_down[l],
        }
        mem_k, mem_v = _memory_kv(mem_prompt, norm_mem_g[l], w_mem_kv[l])
        xp, r_p, s_p, _ = _layer(xp, mem_k, mem_v, prompt_row0, prompt_wkv0, lp)
        mk_p.append(mem_k)
        mv_p.append(mem_v)
        wkv_p.append(s_p.astype(state_wkv.dtype))
        row_p.append(r_p)
        xs, r_s, s_s, vr = _layer(xs, cache_mem_k[l], cache_mem_v[l], state_shift[l], state_wkv[l], lp)
        wkv_s.append(s_s.astype(state_wkv.dtype))
        row_s.append(r_s)
        v_s.append(vr)
    y_prompt = _rmsnorm(xp, norm_final_g)
    y_sample = _rmsnorm(xs, norm_final_g)
    new_cache_mem_k_prompt = jnp.stack(mk_p)
    new_cache_mem_v_prompt = jnp.stack(mv_p)
    new_state_wkv_prompt = jnp.stack(wkv_p)
    new_state_shift_prompt = jnp.stack(row_p)
    new_state_wkv_sample = jnp.stack(wkv_s)
    new_state_shift_sample = jnp.stack(row_s)
    new_sgu_v_sample = jnp.stack(v_s)
    return (y_prompt, y_sample, new_cache_mem_k_prompt, new_cache_mem_v_prompt, new_state_wkv_prompt,
            new_state_shift_prompt, new_state_wkv_sample, new_state_shift_sample, new_sgu_v_sample)
```

```cpp
#include <hip/hip_runtime.h>
#include <hip/hip_cooperative_groups.h>
#include <cstdio>
#include <cstdint>
namespace cg = cooperative_groups;
namespace pg8 {
#define PG8_LAS __attribute__((address_space(3)))
typedef unsigned short bf16_t;
typedef short bf16x8 __attribute__((ext_vector_type(8)));
typedef float f32x4 __attribute__((ext_vector_type(4)));
typedef unsigned u32x4 __attribute__((ext_vector_type(4)));
constexpr int BM = 256, BK = 64, HALF = 128, HTB = HALF * BK * 2  , STAGE_BYTES = 8 * HTB, NXCD = 8, WGM = 8;

__host__ __device__ __forceinline__ int lds_byte(int r, int c) { const int st = (r >> 4) * 2 + (c >> 5), rr = r & 15, cc = c & 31, ob = rr * 64 + cc * 2; return st * 1024 + (ob ^ (((ob >> 9) & 1) << 5)); }
__host__ __device__ __forceinline__ void stage_rc(int b, int& R, int& C) { const int st = b / 1024, sb = b % 1024, swz = sb ^ (((sb >> 9) & 1) << 5); R = (st >> 1) * 16 + swz / 64; C = (st & 1) * 32 + (swz % 64) / 2; }
__host__ __device__ __forceinline__ int perm32(int rho) { const int n = rho >> 4, i = rho & 15; return 8 * (i >> 2) + 4 * n + (i & 3); }

struct Unit { int pm, pn; };
struct Gemm { const bf16_t* A; const bf16_t* Bt; int M, N, K, lda; };

struct StaticOrder {
    int nM, nN, nwg, G, c;
    __host__ __device__ void init(int M, int N, int G_, int c_) { nM = M / BM; nN = N / BM; nwg = nM * nN; G = G_; c = c_; }
    __host__ __device__ bool next(int i, Unit& u) const {
        const long L = (long)i * G + c; if (L >= nwg) return false;
        int wgid = (int)L; { const int q = nwg / NXCD, r = nwg % NXCD, xcd = wgid % NXCD, off = wgid / NXCD; wgid = (xcd < r ? xcd * (q + 1) : r * (q + 1) + (xcd - r) * q) + off; }
        const int nig = WGM * nN, gid = wgid / nig, fm = gid * WGM, gsz = (nM - fm) < WGM ? (nM - fm) : WGM;
        u.pm = fm + ((wgid % nig) % gsz); u.pn = (wgid % nig) / gsz; return true;
    }
    __device__ __forceinline__ void a_ready(const Unit&) const {}
    __device__ __forceinline__ void done(const Unit&) const {}
};

__device__ __forceinline__ unsigned cvt_pk_bf16(float lo, float hi) { unsigned r; asm volatile("v_cvt_pk_bf16_f32 %0, %1, %2" : "=v"(r) : "v"(lo), "v"(hi)); return r; }
typedef float f32x2 __attribute__((ext_vector_type(2)));
__device__ __forceinline__ float fast_sigmoid(float x) { return __builtin_amdgcn_rcpf(1.0f + __expf(-x)); }
__device__ __forceinline__ float gelu_tanh(float x) { const float z = 1.5957691216f * (x + 0.044715f * x * x * x); return x * fast_sigmoid(z); }
__device__ __forceinline__ float bf_lo(unsigned w) { return __uint_as_float(w << 16); }
__device__ __forceinline__ float bf_hi(unsigned w) { return __uint_as_float(w & 0xffff0000u); }

template <int MODE> struct EpiAct {
    static constexpr bool PERM = true, AFTER_DRAIN = false;
    bf16_t* O; int ldc;
    __device__ __forceinline__ void operator()(const f32x4 (&acc)[2][2][4][2], const Unit& u, int wr, int wc, int fr, int fq) const {
        const int row0 = u.pm * BM + wr * 64 + fr; const int col0 = u.pn * BM + wc * 32 + 8 * fq;
#pragma unroll
        for (int ai = 0; ai < 2; ++ai)
#pragma unroll
            for (int m = 0; m < 4; ++m) { bf16_t* rowp = O + (size_t)(row0 + ai * HALF + m * 16) * ldc + col0;
#pragma unroll
                for (int bj = 0; bj < 2; ++bj) { f32x4 v0 = acc[ai][bj][m][0], v1 = acc[ai][bj][m][1];
                    if (MODE == 1) {
#pragma unroll
                        for (int e = 0; e < 4; ++e) { v0[e] = gelu_tanh(v0[e]); v1[e] = gelu_tanh(v1[e]); } }
                    if (MODE == 2) {
#pragma unroll
                        for (int e = 0; e < 4; ++e) { float a = fmaxf(v0[e], 0.f), b = fmaxf(v1[e], 0.f); v0[e] = a * a; v1[e] = b * b; } }
                    u32x4 w; w.x = cvt_pk_bf16(v0[0], v0[1]); w.y = cvt_pk_bf16(v0[2], v0[3]); w.z = cvt_pk_bf16(v1[0], v1[1]); w.w = cvt_pk_bf16(v1[2], v1[3]);
                    *(u32x4*)(rowp + bj * HALF) = w; } }
    }
};
struct EpiGate {
    static constexpr bool PERM = true, AFTER_DRAIN = false;
    const bf16_t* T; bf16_t* MG; int ldc; int first;
    __device__ __forceinline__ void operator()(const f32x4 (&acc)[2][2][4][2], const Unit& u, int wr, int wc, int fr, int fq) const {
        const int row0 = u.pm * BM + wr * 64 + fr; const int col0 = u.pn * BM + wc * 32 + 8 * fq;
#pragma unroll
        for (int ai = 0; ai < 2; ++ai)
#pragma unroll
            for (int m = 0; m < 4; ++m) { const size_t off = (size_t)(row0 + ai * HALF + m * 16) * ldc + col0;
#pragma unroll
                for (int bj = 0; bj < 2; ++bj) { const f32x4 v0 = acc[ai][bj][m][0], v1 = acc[ai][bj][m][1];
                    const u32x4 t = *(const u32x4*)(T + off + bj * HALF);
                    u32x4 g = (u32x4){0u, 0u, 0u, 0u}; if (!first) g = *(const u32x4*)(MG + off + bj * HALF);
                    float o[8];
                    o[0] = bf_lo(g.x) + fast_sigmoid(v0[0]) * bf_lo(t.x); o[1] = bf_hi(g.x) + fast_sigmoid(v0[1]) * bf_hi(t.x);
                    o[2] = bf_lo(g.y) + fast_sigmoid(v0[2]) * bf_lo(t.y); o[3] = bf_hi(g.y) + fast_sigmoid(v0[3]) * bf_hi(t.y);
                    o[4] = bf_lo(g.z) + fast_sigmoid(v1[0]) * bf_lo(t.z); o[5] = bf_hi(g.z) + fast_sigmoid(v1[1]) * bf_hi(t.z);
                    o[6] = bf_lo(g.w) + fast_sigmoid(v1[2]) * bf_lo(t.w); o[7] = bf_hi(g.w) + fast_sigmoid(v1[3]) * bf_hi(t.w);
                    u32x4 w; w.x = cvt_pk_bf16(o[0], o[1]); w.y = cvt_pk_bf16(o[2], o[3]); w.z = cvt_pk_bf16(o[4], o[5]); w.w = cvt_pk_bf16(o[6], o[7]);
                    *(u32x4*)(MG + off + bj * HALF) = w; } }
    }
};
struct EpiResid {
    static constexpr bool PERM = false, AFTER_DRAIN = false;
    float* X; int ldc;
    __device__ __forceinline__ void operator()(const f32x4 (&acc)[2][2][4][2], const Unit& u, int wr, int wc, int fr, int fq) const {
        const int row0 = u.pm * BM + wr * 64 + fr; const int col0 = u.pn * BM + wc * 32 + 4 * fq;
#pragma unroll
        for (int ai = 0; ai < 2; ++ai)
#pragma unroll
            for (int m = 0; m < 4; ++m) { float* rowp = X + (size_t)(row0 + ai * HALF + m * 16) * ldc + col0;
#pragma unroll
                for (int bj = 0; bj < 2; ++bj)
#pragma unroll
                    for (int n = 0; n < 2; ++n) { f32x4* p = (f32x4*)(rowp + bj * HALF + n * 16); const f32x4 x = *p; *p = x + acc[ai][bj][m][n]; } }
    }
};
struct EpiMemKV {
    static constexpr bool PERM = false, AFTER_DRAIN = false;
    float* mk; float* mv;
    __device__ __forceinline__ void operator()(const f32x4 (&acc)[2][2][4][2], const Unit& u, int wr, int wc, int fr, int fq) const {
        const int l = u.pm >> 3; const int row0 = (u.pm & 7) * BM + wr * 64 + fr; int colt = (u.pn & 7) * BM;
        float* base = mk + (colt < 1024 ? (size_t)0 : (size_t)(mv - mk)) + (size_t)l * 2048 * 1024; colt &= 1023;
        const int col0 = colt + wc * 32 + 4 * fq;
#pragma unroll
        for (int ai = 0; ai < 2; ++ai)
#pragma unroll
            for (int m = 0; m < 4; ++m) { float* rowp = base + (size_t)(row0 + ai * HALF + m * 16) * 1024 + col0;
#pragma unroll
                for (int bj = 0; bj < 2; ++bj)
#pragma unroll
                    for (int n = 0; n < 2; ++n) *(f32x4*)(rowp + bj * HALF + n * 16) = acc[ai][bj][m][n]; }
    }
};
struct MemKVOrder {
    int G, c;
    __host__ __device__ bool next(int i, Unit& u) const { const int L = i * G + c; if (L >= 256) return false; const int l = L >> 6, r = L & 63; u.pm = l * 8 + (r >> 3); u.pn = l * 8 + (r & 7); return true; }
    __device__ __forceinline__ void a_ready(const Unit&) const {}
    __device__ __forceinline__ void done(const Unit&) const {}
};
struct EpiU {
    static constexpr bool AFTER_DRAIN = false;
    int mode; bool perm; bf16_t* O; const bf16_t* T; float* F; float* F2; int ldc; int first;
    __device__ __forceinline__ void operator()(const f32x4 (&acc)[2][2][4][2], const Unit& u, int wr, int wc, int fr, int fq) const {
        if (mode == 0) { EpiAct<0> e{O, ldc}; e(acc, u, wr, wc, fr, fq); }
        else if (mode == 1) { EpiAct<1> e{O, ldc}; e(acc, u, wr, wc, fr, fq); }
        else if (mode == 2) { EpiAct<2> e{O, ldc}; e(acc, u, wr, wc, fr, fq); }
        else if (mode == 3) { EpiGate e{T, O, ldc, first}; e(acc, u, wr, wc, fr, fq); }
        else if (mode == 4) { EpiResid e{F, ldc}; e(acc, u, wr, wc, fr, fq); }
        else { EpiMemKV e{F, F2}; e(acc, u, wr, wc, fr, fq); }
    }
};
struct OrderU {
    StaticOrder so; int memkv; int half;
    __device__ bool next(int i, Unit& u) const {
        if (half) { if (!so.next(i, u)) return false; const int tpb = half == 2 ? 23 : 9; const int bq = u.pm / tpb; u.pm = bq * 32 + (u.pm - bq * tpb) + (half == 2 ? 9 : 0); return true; }
        if (memkv) { const int L = i * so.G + so.c; if (L >= 256) return false; const int l = L >> 6, r = L & 63; u.pm = l * 8 + (r >> 3); u.pn = l * 8 + (r & 7); return true; }
        return so.next(i, u);
    }
    __device__ __forceinline__ void a_ready(const Unit&) const {}
    __device__ __forceinline__ void done(const Unit&) const {}
};
template <class Epi, class Sched, bool ALIGN_EPI = false, bool SP2 = false>
__device__ __forceinline__ void gemm_phase(PG8_LAS unsigned char* lds, const Gemm g, const Sched& S, const Epi& E) {
    int tid_ = threadIdx.x; asm volatile("" : "+v"(tid_)); const int tid = tid_, wid = __builtin_amdgcn_readfirstlane(tid >> 6), lane = tid & 63, wr = wid >> 2, wc = wid & 3, fr = lane & 15, fq = lane >> 4;
    const int K = g.K, nt = K / BK;
    unsigned voffA[2], voffB[2];
#pragma unroll
    for (int i = 0; i < 2; ++i) { int R, C; stage_rc(tid * 16 + i * 8192, R, C); const int Rb = E.perm ? ((R & ~31) + perm32(R & 31)) : R;
        voffA[i] = (unsigned)(R * g.lda + C) * 2u; voffB[i] = (unsigned)(Rb * K + C) * 2u; }
    const size_t kstep = (size_t)(BK * 2);
    const size_t hstep = (size_t)HALF * K * 2;
    const size_t tstep = 2 * hstep;
    const size_t hstepA = (size_t)HALF * g.lda * 2, tstepA = 2 * hstepA;
    const unsigned ldsw = (unsigned)wid * 1024u;
    const int aoff = lds_byte(wr * 64 + fr, fq * 8), boff = lds_byte(wc * 32 + fr, fq * 8);
#define PG8_SA(b, h) (((b) * 2 + (h)) * HTB)
#define PG8_SB(b, h) ((4 + (b) * 2 + (h)) * HTB)
#define PG8_STAGE(bufoff, gbase, voff) do { _Pragma("unroll") for (int _i = 0; _i < 2; ++_i) \
        __builtin_amdgcn_global_load_lds((const unsigned*)((const char*)(gbase) + (voff)[_i]), (PG8_LAS unsigned*)(lds + (bufoff) + ldsw + _i * 8192), 16, 0, 0); } while (0)
#define PG8_LDA(dst, b, h) do { _Pragma("unroll") for (int m = 0; m < 4; ++m) _Pragma("unroll") for (int k = 0; k < 2; ++k) dst[m][k] = *(const PG8_LAS bf16x8*)(lds + PG8_SA(b, h) + aoff + m * 2048 + k * 1024); } while (0)
#define PG8_LDB(dst, b, h) do { _Pragma("unroll") for (int n = 0; n < 2; ++n) _Pragma("unroll") for (int k = 0; k < 2; ++k) dst[n][k] = *(const PG8_LAS bf16x8*)(lds + PG8_SB(b, h) + boff + n * 2048 + k * 1024); } while (0)
#define PG8_MMA(ai, bj, At, Bt) do { __builtin_amdgcn_s_setprio(1); _Pragma("unroll") for (int m = 0; m < 4; ++m) _Pragma("unroll") for (int n = 0; n < 2; ++n) _Pragma("unroll") for (int k = 0; k < 2; ++k) \
        acc[ai][bj][m][n] = __builtin_amdgcn_mfma_f32_16x16x32_bf16(Bt[n][k], At[m][k], acc[ai][bj][m][n], 0, 0, 0); __builtin_amdgcn_s_setprio(0); } while (0)
#define PG8_WAIT_V(n) asm volatile("s_waitcnt vmcnt(" #n ")" ::: "memory")
#define PG8_WAIT_L(n) asm volatile("s_waitcnt lgkmcnt(" #n ")" ::: "memory")
#define PG8_BAR __builtin_amdgcn_s_barrier()
#define PG8_SCHED __builtin_amdgcn_sched_barrier(0)
    Unit cur, nxt; int ui = 0;
    if (!S.next(0, cur)) return;
    f32x4 acc[2][2][4][2];
#pragma unroll
    for (int a = 0; a < 2; ++a)
#pragma unroll
        for (int b = 0; b < 2; ++b)
#pragma unroll
            for (int m = 0; m < 4; ++m)
#pragma unroll
                for (int n = 0; n < 2; ++n) acc[a][b][m][n] = (f32x4){0.f, 0.f, 0.f, 0.f};
    bf16x8 At[4][2], B0[2][2], B1[2][2];
    const char* cA = (const char*)g.A + (size_t)cur.pm * tstepA; const char* cB = (const char*)g.Bt + (size_t)cur.pn * tstep;
    S.a_ready(cur);
    if constexpr (SP2) {
        PG8_STAGE(PG8_SB(0, 0), cB, voffB); PG8_STAGE(PG8_SB(0, 1), cB + hstep, voffB); PG8_STAGE(PG8_SA(0, 0), cA, voffA); PG8_STAGE(PG8_SA(0, 1), cA + hstepA, voffA);
        if (wr == 1) PG8_BAR;
        PG8_WAIT_V(2); PG8_BAR;
        PG8_STAGE(PG8_SB(1, 0), cB + kstep, voffB); PG8_STAGE(PG8_SA(1, 0), cA + kstep, voffA); PG8_STAGE(PG8_SB(1, 1), cB + hstep + kstep, voffB);
        PG8_WAIT_V(6); PG8_BAR;
    } else {
        PG8_STAGE(PG8_SB(0, 0), cB, voffB); PG8_STAGE(PG8_SA(0, 0), cA, voffA); PG8_STAGE(PG8_SB(0, 1), cB + hstep, voffB); PG8_STAGE(PG8_SA(0, 1), cA + hstepA, voffA);
        if (wr == 1) PG8_BAR;
        PG8_WAIT_V(4); PG8_BAR;
        PG8_STAGE(PG8_SB(1, 0), cB + kstep, voffB); PG8_STAGE(PG8_SA(1, 0), cA + kstep, voffA); PG8_STAGE(PG8_SB(1, 1), cB + hstep + kstep, voffB);
        PG8_WAIT_V(6); PG8_BAR;
    }
    for (;;) {
        const bool has_next = S.next(ui + 1, nxt);
        const char* nA = has_next ? (const char*)g.A + (size_t)nxt.pm * tstepA : cA; const char* nB = has_next ? (const char*)g.Bt + (size_t)nxt.pn * tstep : cB;
        for (int t = 0; t < nt; t += 2) {
            const bool last = (t == nt - 2);
            const char* a1 = cA + (size_t)(t + 1) * kstep;
            const char* a2 = last ? nA : cA + (size_t)(t + 2) * kstep; const char* b2 = last ? nB : cB + (size_t)(t + 2) * kstep;
            const char* a3 = a2 + kstep; const char* b3 = b2 + kstep;
            if (last && has_next) S.a_ready(nxt);
            if constexpr (SP2) {
            PG8_LDB(B0, 0, 0); PG8_LDB(B1, 0, 1); PG8_SCHED; PG8_LDA(At, 0, 0); PG8_STAGE(PG8_SA(1, 1), a1 + hstepA, voffA);
            PG8_WAIT_V(8); PG8_WAIT_L(0); PG8_BAR; PG8_MMA(0, 0, At, B0); PG8_MMA(0, 1, At, B1); PG8_BAR; PG8_SCHED;
            PG8_LDA(At, 0, 1); PG8_STAGE(PG8_SB(0, 0), b2, voffB); PG8_STAGE(PG8_SB(0, 1), b2 + hstep, voffB); PG8_STAGE(PG8_SA(0, 0), a2, voffA);
            PG8_WAIT_V(8); PG8_WAIT_L(0); PG8_BAR; PG8_MMA(1, 0, At, B0); PG8_MMA(1, 1, At, B1); PG8_BAR; PG8_SCHED;
            PG8_LDB(B0, 1, 0); PG8_LDB(B1, 1, 1); PG8_SCHED; PG8_LDA(At, 1, 0); PG8_STAGE(PG8_SA(0, 1), a2 + hstepA, voffA);
            PG8_WAIT_V(8); PG8_WAIT_L(0); PG8_BAR; PG8_MMA(0, 0, At, B0); PG8_MMA(0, 1, At, B1); PG8_BAR; PG8_SCHED;
            PG8_LDA(At, 1, 1); PG8_STAGE(PG8_SB(1, 0), b3, voffB); PG8_STAGE(PG8_SB(1, 1), b3 + hstep, voffB); PG8_STAGE(PG8_SA(1, 0), a3, voffA);
            PG8_WAIT_V(8); PG8_WAIT_L(0); PG8_BAR; PG8_MMA(1, 0, At, B0); PG8_MMA(1, 1, At, B1); PG8_BAR; PG8_SCHED;
            } else {
            PG8_LDB(B0, 0, 0); PG8_SCHED; PG8_LDA(At, 0, 0); PG8_STAGE(PG8_SA(1, 1), a1 + hstepA, voffA);
            PG8_WAIT_L(8); PG8_BAR; PG8_WAIT_L(0); PG8_MMA(0, 0, At, B0); PG8_BAR; PG8_SCHED;
            PG8_LDB(B1, 0, 1); PG8_STAGE(PG8_SB(0, 0), b2, voffB);
            PG8_BAR; PG8_WAIT_L(0); PG8_MMA(0, 1, At, B1); PG8_BAR;
            PG8_LDA(At, 0, 1); PG8_STAGE(PG8_SA(0, 0), a2, voffA);
            PG8_BAR; PG8_WAIT_L(0); PG8_MMA(1, 0, At, B0); PG8_BAR; PG8_SCHED;
            PG8_STAGE(PG8_SB(0, 1), b2 + hstep, voffB);
            PG8_WAIT_V(6); PG8_BAR; PG8_MMA(1, 1, At, B1); PG8_BAR;
            PG8_LDB(B0, 1, 0); PG8_SCHED; PG8_LDA(At, 1, 0); PG8_STAGE(PG8_SA(0, 1), a2 + hstepA, voffA);
            PG8_WAIT_L(8); PG8_BAR; PG8_WAIT_L(0); PG8_MMA(0, 0, At, B0); PG8_BAR; PG8_SCHED;
            PG8_LDB(B1, 1, 1); PG8_STAGE(PG8_SB(1, 0), b3, voffB);
            PG8_BAR; PG8_WAIT_L(0); PG8_MMA(0, 1, At, B1); PG8_BAR;
            PG8_LDA(At, 1, 1); PG8_STAGE(PG8_SA(1, 0), a3, voffA);
            PG8_BAR; PG8_WAIT_L(0); PG8_MMA(1, 0, At, B0); PG8_BAR; PG8_SCHED;
            PG8_STAGE(PG8_SB(1, 1), b3 + hstep, voffB);
            PG8_WAIT_V(6); PG8_BAR; PG8_MMA(1, 1, At, B1); PG8_BAR;
            }
        }
        if constexpr (ALIGN_EPI) { if (wr == 0) PG8_BAR; }
        if constexpr (!Epi::AFTER_DRAIN) { E(acc, cur, wr, wc, fr, fq); S.done(cur); }
        if (!has_next) break;
#pragma unroll
        for (int a = 0; a < 2; ++a)
#pragma unroll
            for (int b = 0; b < 2; ++b)
#pragma unroll
                for (int m = 0; m < 4; ++m)
#pragma unroll
                    for (int n = 0; n < 2; ++n) acc[a][b][m][n] = (f32x4){0.f, 0.f, 0.f, 0.f};
        cur = nxt; cA = nA; cB = nB; ++ui;
        if constexpr (ALIGN_EPI) { if (wr == 1) PG8_BAR; }
    }
    PG8_WAIT_V(0);
    if constexpr (!ALIGN_EPI) { if (wr == 0) PG8_BAR; }
    PG8_BAR;
    if constexpr (Epi::AFTER_DRAIN) { E.fused(acc, cur, wr, wc, fr, fq, lds, wid, lane); S.done(cur); }
#undef PG8_SA
#undef PG8_SB
#undef PG8_STAGE
#undef PG8_LDA
#undef PG8_LDB
#undef PG8_MMA
#undef PG8_WAIT_V
#undef PG8_WAIT_L
#undef PG8_BAR
#undef PG8_SCHED
}
}
#define LAS __attribute__((address_space(3)))
typedef unsigned short bf16;
typedef unsigned v4u __attribute__((ext_vector_type(4)));
typedef unsigned v2u __attribute__((ext_vector_type(2)));
typedef float f32x4 __attribute__((ext_vector_type(4)));
typedef float f32x2 __attribute__((ext_vector_type(2)));
typedef short bf16x8 __attribute__((ext_vector_type(8)));
constexpr int NT = 512, NWAVES = 8;
constexpr int DM = 1024, NB = 8, SEQ = 8192, DEPTH = 4, DECS = 32;
constexpr int MP = NB * SEQ, MS = NB * DECS, M = MP + MS;
constexpr int RC = 3328, INC = 9472, COL_GMLP = 3328, COL_Q = 5376, COL_GATE = 6400, DFF = 4096;
constexpr int NMEM = 256;
constexpr size_t O_Y = 0, O_MK = (size_t)M * DM, O_MV = O_MK + (size_t)DEPTH * NB * NMEM * DM, O_WKVP = O_MV + (size_t)DEPTH * NB * NMEM * DM,
    O_SHP = O_WKVP + (size_t)DEPTH * NB * 16 * 64 * 64, O_WKVS = O_SHP + (size_t)DEPTH * NB * RC, O_SHS = O_WKVS + (size_t)DEPTH * NB * 16 * 64 * 64,
    O_SGUV = O_SHS + (size_t)DEPTH * NB * RC, O_END = O_SGUV + (size_t)DEPTH * NB * DECS * DM;
constexpr size_t A1 = (size_t)M * DM * 2;
constexpr size_t WS_WIN = 1u << 20;
constexpr size_t WS_WB = WS_WIN + (size_t)INC * DM * 2;
constexpr size_t WS_WOUT = WS_WB + 3ull * DM * DM * 2;
constexpr size_t WS_WUP = WS_WOUT + (size_t)DM * DM * 2;
constexpr size_t WS_WDN = WS_WUP + (size_t)DFF * DM * 2;
constexpr size_t WS_W2T = WS_WDN + (size_t)DFF * DM * 2;
constexpr size_t WS_A2T = WS_W2T + 1024 * 64 * 2;
constexpr size_t WS_G2T = WS_A2T + 1024 * 64 * 2;
constexpr size_t WS_WS = WS_G2T + 1024 * 128 * 2;
constexpr size_t WS_KB = WS_WS + 8 * 128 * 128 * 2;
constexpr size_t WS_VT = WS_KB + 16ull * 256 * 1024 * 2;
constexpr size_t WS_H = WS_VT + 16ull * 256 * 1024 * 2;
constexpr size_t WS_Y = WS_H + A1, WS_T = WS_Y + A1, WS_MG = WS_T + A1, WS_BIG = WS_MG + A1;
constexpr size_t WS_END = WS_BIG + (size_t)M * RC * 2;
constexpr size_t WS_UVB = WS_T;
constexpr size_t WS_T2 = WS_BIG, WS_MG2 = WS_BIG + A1;
constexpr size_t WS_UP = WS_Y;
static_assert(WS_UP + (size_t)M * DFF * 2 <= WS_END, "up overlay");
constexpr size_t WS_AMEM = WS_BIG;
constexpr size_t WS_WMKV = WS_BIG + 4ull * 2048 * 1024 * 2;
static_assert(WS_END <= (1024ull << 20), "workspace");
constexpr int LDS_BYTES = 147456;

struct Args { const float* in[32]; float* out; unsigned char* ws; };

__device__ __forceinline__ unsigned f2bf(float f) { unsigned u = __builtin_bit_cast(unsigned, f); return (u + 0x7fffu + ((u >> 16) & 1u)) >> 16; }
__device__ __forceinline__ unsigned pk2(float lo, float hi) { return pg8::cvt_pk_bf16(lo, hi); }
typedef __bf16 bf16x2_t __attribute__((ext_vector_type(2)));
__device__ __forceinline__ unsigned pk2c(float lo, float hi) { const f32x2 v = {lo, hi}; const bf16x2_t b = __builtin_convertvector(v, bf16x2_t); return __builtin_bit_cast(unsigned, b); }
__device__ __forceinline__ float bflo(unsigned w) { return __uint_as_float(w << 16); }
__device__ __forceinline__ float bfhi(unsigned w) { return __uint_as_float(w & 0xffff0000u); }
__device__ __forceinline__ void unpack8(const v4u w, float* o) { o[0] = bflo(w.x); o[1] = bfhi(w.x); o[2] = bflo(w.y); o[3] = bfhi(w.y); o[4] = bflo(w.z); o[5] = bfhi(w.z); o[6] = bflo(w.w); o[7] = bfhi(w.w); }
__device__ __forceinline__ v4u pack8(const float* o) { v4u w; w.x = pk2(o[0], o[1]); w.y = pk2(o[2], o[3]); w.z = pk2(o[4], o[5]); w.w = pk2(o[6], o[7]); return w; }
__device__ __forceinline__ float wave_sum(float v) {
#pragma unroll
    for (int o = 1; o < 64; o <<= 1) v += __shfl_xor(v, o);
    return v;
}
template <int CTRL> __device__ __forceinline__ float dppf(float x) { return __builtin_bit_cast(float, __builtin_amdgcn_mov_dpp(__builtin_bit_cast(int, x), CTRL, 0xf, 0xf, true)); }
__device__ __forceinline__ float row16_sum(float v) { v += dppf<0xB1>(v); v += dppf<0x4E>(v); v += dppf<0x141>(v); v += dppf<0x128>(v); return v; }
#define LDS_WAIT() asm volatile("s_waitcnt lgkmcnt(0)" ::: "memory")
__device__ __forceinline__ void sub_barrier(unsigned* cnt, unsigned target, int mode = 0, unsigned* cnt2 = nullptr, unsigned target2 = 0u) {
    asm volatile("s_waitcnt vmcnt(0)" ::: "memory");
    __syncthreads();
    if (threadIdx.x == 0) {
        __builtin_amdgcn_fence(__ATOMIC_RELEASE, "agent");
        asm volatile("s_waitcnt vmcnt(0)" ::: "memory");
        __hip_atomic_fetch_add(cnt, 1u, __ATOMIC_RELAXED, __HIP_MEMORY_SCOPE_AGENT);
        if (mode != 1) {
            while (__hip_atomic_load(cnt, __ATOMIC_RELAXED, __HIP_MEMORY_SCOPE_AGENT) < target) __builtin_amdgcn_s_sleep(2);
            if (cnt2) while (__hip_atomic_load(cnt2, __ATOMIC_RELAXED, __HIP_MEMORY_SCOPE_AGENT) < target2) __builtin_amdgcn_s_sleep(2);
            __builtin_amdgcn_fence(__ATOMIC_ACQUIRE, "agent");
            asm volatile("s_waitcnt vmcnt(0)" ::: "memory");
        }
    }
    __syncthreads();
}
__device__ __forceinline__ void transpose_item(const float* W, int ldw, int N, bf16* WT, int ldt, LAS float* scr, int item, int lane, bool vperm) {
    const int nblk = N / 32, kb = item / nblk, nb = item % nblk, k0 = 64 * kb, n0 = 32 * nb;
#pragma unroll 8
    for (int i = 0; i < 32; ++i) { const int kk = 2 * i + (lane >> 5); scr[kk * 33 + (lane & 31)] = W[(size_t)(k0 + kk) * ldw + n0 + (lane & 31)]; }
    LDS_WAIT();
    const int c = lane & 7;
    const int rlo = vperm ? ((c >> 2) * 32 + 4 * (c & 3)) : 8 * c, rhi = vperm ? rlo + 16 : rlo + 4;
#pragma unroll
    for (int j = 0; j < 4; ++j) { const int n = (lane >> 3) + 8 * j; const LAS float* s = scr + rlo * 33 + n; const LAS float* s2 = scr + rhi * 33 + n;
        v4u o; o.x = pk2(s[0 * 33], s[1 * 33]); o.y = pk2(s[2 * 33], s[3 * 33]); o.z = pk2(s2[0 * 33], s2[1 * 33]); o.w = pk2(s2[2 * 33], s2[3 * 33]);
        *(v4u*)(WT + (size_t)(n0 + n) * ldt + k0 + 8 * c) = o; }
    LDS_WAIT();
}
__device__ __forceinline__ void rms_row_bf16(const float* xrow, const float* g, bf16* orow, int lane) {
    const f32x4* xr = (const f32x4*)xrow + lane; const f32x4* gr = (const f32x4*)g + lane;
    f32x4 v[4]; float s = 0.f;
#pragma unroll
    for (int j = 0; j < 4; ++j) { v[j] = xr[64 * j]; s += (v[j].x * v[j].x + v[j].y * v[j].y) + (v[j].z * v[j].z + v[j].w * v[j].w); }
    const float r = 1.0f / sqrtf(wave_sum(s) * (1.f / DM) + 1e-6f);
    v2u* o8 = (v2u*)orow + lane;
#pragma unroll
    for (int j = 0; j < 4; ++j) { const f32x4 gg = gr[64 * j]; v2u w; w.x = pk2(v[j].x * r * gg.x, v[j].y * r * gg.y); w.y = pk2(v[j].z * r * gg.z, v[j].w * r * gg.w); o8[64 * j] = w; }
}

struct Ctx {
    const float* const* in; float* out; unsigned char* ws; LAS unsigned char* lds;
    int tid, lane, wave, gw, ngw;
};

__device__ __forceinline__ void prep_phase(const Ctx& C, int kind, int l2) {
    LAS float* scr = (LAS float*)(C.lds + C.wave * 16384);
    constexpr int I_IN = 16 * (INC / 32), I_SQ = 16 * 32, I_UP = 16 * (DFF / 32), I_DN = 64 * 32, I_L64 = 32, I_L128 = 64, I_VT = 16 * 4 * 32;
    constexpr int NIT = I_IN + 4 * I_SQ + I_UP + I_DN + 2 * I_L64 + I_L128 + I_VT;
    constexpr int ITM = (1024 / 64) * (2048 / 32);
    const int l = kind >= 0 ? kind : 0;
    const int nit = kind >= 0 ? NIT : kind == -1 ? 4 * ITM : 0;
    for (int it = C.gw; it < nit; it += C.ngw) {
        int r = it; const float* src; int ldw, N, ldt; size_t dst; bool vperm = false;
        if (kind < 0) { const int ll = it / ITM; r = it % ITM; src = C.in[12] + (size_t)ll * 1024 * 2048; ldw = 2048; N = 2048; dst = WS_WMKV + (size_t)ll * 2048 * 1024 * 2; ldt = 1024; }
        else if (r < I_IN) { src = C.in[11] + (size_t)l * DM * INC; ldw = INC; N = INC; dst = WS_WIN; ldt = DM; }
        else if ((r -= I_IN) < 3 * I_SQ) { const int b = r / I_SQ; r = r % I_SQ; src = C.in[28] + ((size_t)l * 3 + b) * DM * DM; ldw = DM; N = DM; dst = WS_WB + (size_t)b * DM * DM * 2; ldt = DM; }
        else if ((r -= 3 * I_SQ) < I_SQ) { src = C.in[29] + (size_t)l * DM * DM; ldw = DM; N = DM; dst = WS_WOUT; ldt = DM; }
        else if ((r -= I_SQ) < I_UP) { src = C.in[30] + (size_t)l * DM * DFF; ldw = DFF; N = DFF; dst = WS_WUP; ldt = DM; }
        else if ((r -= I_UP) < I_DN) { src = C.in[31] + (size_t)l * DFF * DM; ldw = DM; N = DM; dst = WS_WDN; ldt = DFF; }
        else if ((r -= I_DN) < I_L64) { src = C.in[15] + (size_t)l * 64 * DM; ldw = DM; N = DM; dst = WS_W2T; ldt = 64; }
        else if ((r -= I_L64) < I_L64) { src = C.in[17] + (size_t)l * 64 * DM; ldw = DM; N = DM; dst = WS_A2T; ldt = 64; }
        else if ((r -= I_L64) < I_L128) { src = C.in[18] + (size_t)l * 128 * DM; ldw = DM; N = DM; dst = WS_G2T; ldt = 128; }
        else { r -= I_L128; const int bbh = r >> 5, bb = bbh >> 2, h = bbh & 3; r &= 31;
            src = (bb < 8 ? C.out + O_MV + ((size_t)l * 8 + bb) * 256 * 1024 : C.in[3] + ((size_t)l * 8 + (bb - 8)) * 256 * 1024) + h * 256;
            ldw = 1024; N = 256; dst = WS_VT + (size_t)bbh * 65536 * 2; ldt = 256; vperm = true; }
        transpose_item(src, ldw, N, (bf16*)(C.ws + dst), ldt, scr, r, C.lane, vperm);
    }
    if (kind == -1) {
        float* X = C.out;
        const f32x4* s = (const f32x4*)C.in[0]; f32x4* d = (f32x4*)X; const size_t n = (size_t)MP * DM / 4;
        for (size_t i = (size_t)blockIdx.x * NT + C.tid; i < n; i += (size_t)gridDim.x * NT) d[i] = s[i];
        const f32x4* s2 = (const f32x4*)C.in[1]; f32x4* d2 = (f32x4*)(X + (size_t)MP * DM); const size_t n2 = (size_t)MS * DM / 4;
        for (size_t i = (size_t)blockIdx.x * NT + C.tid; i < n2; i += (size_t)gridDim.x * NT) d2[i] = s2[i];
    }
    if (kind >= 0) {
        { v4u* d = (v4u*)(C.ws + WS_KB); const size_t n = 16ull * 256 * 1024 / 8;
          for (size_t i = (size_t)blockIdx.x * NT + C.tid; i < n; i += (size_t)gridDim.x * NT) { const size_t e = i * 8; const int bb = (int)(e >> 18); const size_t o = e & 262143;
              const float* s = (bb < 8 ? C.out + O_MK + ((size_t)l * 8 + bb) * 262144 : C.in[2] + ((size_t)l * 8 + (bb - 8)) * 262144) + o;
              const f32x4 a = *(const f32x4*)s, b = *(const f32x4*)(s + 4); v4u w; w.x = pk2(a.x, a.y); w.y = pk2(a.z, a.w); w.z = pk2(b.x, b.y); w.w = pk2(b.z, b.w); d[i] = w; } }
        { bf16* d = (bf16*)(C.ws + WS_WS); const float* s = C.in[26] + (size_t)l * 8 * 128 * 128;
          for (int i = blockIdx.x * NT + C.tid; i < 8 * 128 * 128; i += gridDim.x * NT) { const int ii = (i >> 7) & 127, jj = i & 127; d[i] = (bf16)f2bf(jj <= ii ? s[i] : 0.f); } }
    }
    { const float* sb; const float* gb; size_t db; int nrows, smask, gshift;
      if (kind == -1) { sb = C.in[6]; gb = C.in[8]; db = WS_AMEM; nrows = 4 * 2048; smask = 2047; gshift = 11; }
      else { sb = C.out; gb = (kind >= 0 ? C.in[7] : C.in[9]) + (kind >= 0 ? l : l2) * DM; db = WS_H; nrows = M; smask = 0x7fffffff; gshift = 30; }
      for (int it = C.gw; it < nrows; it += 2 * C.ngw) { const int it2 = it + C.ngw;
          const f32x4* xa = (const f32x4*)(sb + (size_t)(it & smask) * DM) + C.lane; const bool has2 = it2 < nrows; const f32x4* xb = (const f32x4*)(sb + (size_t)((has2 ? it2 : it) & smask) * DM) + C.lane;
          f32x4 va[4], vb[4]; float sa = 0.f, sb2 = 0.f;
#pragma unroll
          for (int j = 0; j < 4; ++j) { va[j] = xa[64 * j]; vb[j] = xb[64 * j]; }
#pragma unroll
          for (int j = 0; j < 4; ++j) { sa += (va[j].x * va[j].x + va[j].y * va[j].y) + (va[j].z * va[j].z + va[j].w * va[j].w); sb2 += (vb[j].x * vb[j].x + vb[j].y * vb[j].y) + (vb[j].z * vb[j].z + vb[j].w * vb[j].w); }
          const float ra = 1.0f / sqrtf(wave_sum(sa) * (1.f / DM) + 1e-6f), rb = 1.0f / sqrtf(wave_sum(sb2) * (1.f / DM) + 1e-6f);
          const f32x4* ga = (const f32x4*)(gb + (size_t)(it >> gshift) * DM) + C.lane; const f32x4* gb2 = (const f32x4*)(gb + (size_t)((has2 ? it2 : it) >> gshift) * DM) + C.lane;
          v2u* oa = (v2u*)((bf16*)(C.ws + db) + (size_t)it * DM) + C.lane; v2u* ob = (v2u*)((bf16*)(C.ws + db) + (size_t)(has2 ? it2 : it) * DM) + C.lane;
#pragma unroll
          for (int j = 0; j < 4; ++j) { const f32x4 g1 = ga[64 * j], g2 = gb2[64 * j]; v2u w1, w2;
              w1.x = pk2(va[j].x * ra * g1.x, va[j].y * ra * g1.y); w1.y = pk2(va[j].z * ra * g1.z, va[j].w * ra * g1.w); oa[64 * j] = w1;
              w2.x = pk2(vb[j].x * rb * g2.x, vb[j].y * rb * g2.y); w2.y = pk2(vb[j].z * rb * g2.z, vb[j].w * rb * g2.w); if (has2) ob[64 * j] = w2; } } }
}

constexpr int RW_MAIN = 0, RW_MSTR = 20608, RW_POST = 41216, RW_YC = 66176, RW_XL = 74368, RW_ZR = 83072, RW_LW = 95360, RW_MU = 131200;
struct RawRegs { v4u cur[4]; v4u prv[4]; };
__device__ __forceinline__ float row8_sum(float v) { v += dppf<0xB1>(v); v += dppf<0x4E>(v); v += dppf<0x141>(v); return v; }
__device__ __forceinline__ void rw_issue(RawRegs& rr, const bf16* PRu, int T, int cn, int pw, const int (&ioff)[4], const int (&itl)[4]) {
    const bf16* pc = PRu + (size_t)cn * (16 * RC);
#pragma unroll
    for (int j = 0; j < 4; ++j) { const int t = cn * 16 + 4 * pw + itl[j];
        rr.cur[j] = (v4u){0u, 0u, 0u, 0u}; rr.prv[j] = (v4u){0u, 0u, 0u, 0u};
        if (ioff[j] >= 0 && t < T) { rr.cur[j] = *(const v4u*)(pc + ioff[j]); if (t > 0) rr.prv[j] = *(const v4u*)(pc + ioff[j] - RC); } }
}
template <int KIND> __device__ __forceinline__ void rw_a1_item(const v4u cw, const v4u pw_, int t, int t4, int q, int tok, const LAS float* MU, LAS float* Mb, LAS float* Pf, LAS bf16* XLw) {
    float cur[8], prv[8]; unpack8(cw, cur); unpack8(pw_, prv);
    if (t == 0) { const f32x4 x0 = *(const LAS f32x4*)(MU + 448 + q * 8), x1 = *(const LAS f32x4*)(MU + 452 + q * 8);
        prv[0] = x0.x; prv[1] = x0.y; prv[2] = x0.z; prv[3] = x0.w; prv[4] = x1.x; prv[5] = x1.y; prv[6] = x1.z; prv[7] = x1.w; }
    const f32x4 m0 = *(const LAS f32x4*)(MU + q * 8), m1 = *(const LAS f32x4*)(MU + q * 8 + 4);
    const float mm[8] = {m0.x, m0.y, m0.z, m0.w, m1.x, m1.y, m1.z, m1.w}; float mx[8];
#pragma unroll
    for (int e = 0; e < 8; ++e) mx[e] = cur[e] + (prv[e] - cur[e]) * mm[e];
    if (KIND == 0) { LAS float* dst = (q < 8 ? Mb : q < 16 ? Mb + 1024 : Pf + 1024) + tok * 64 + (q & 7) * 8;
        *(LAS f32x4*)dst = (f32x4){mx[0], mx[1], mx[2], mx[3]}; *(LAS f32x4*)(dst + 4) = (f32x4){mx[4], mx[5], mx[6], mx[7]}; }
    else { float o[8];
#pragma unroll
        for (int e = 0; e < 8; ++e) { if (KIND == 1) o[e] = mx[e]; else if (KIND == 2) { const float ex = __expf(2.0f * mx[e]); o[e] = 1.0f - 2.0f * __builtin_amdgcn_rcpf(ex + 1.0f); } else o[e] = pg8::fast_sigmoid(mx[e]); }
        *(LAS v4u*)(XLw + t4 * 264 + (q - 24) * 8) = pack8(o); }
}
__device__ __forceinline__ void rwkv_unit(const Ctx& C, int l, int sample, int b, int h) {
    LAS unsigned char* L = C.lds;
    const int T = sample ? DECS : SEQ, NC = T / 16; const size_t rowbase = sample ? (size_t)MP + (size_t)b * DECS : (size_t)b * SEQ;
    const bf16* PR = (const bf16*)(C.ws + WS_BIG); bf16* Yg = (bf16*)(C.ws + WS_Y);
    const int lane = C.lane, w = C.wave;
    __syncthreads();
    if (w < 4) {
        const int rowl = lane & 15, fq = lane >> 4, row = 16 * w + rowl;
        const unsigned m0 = fq == 0 ? 0xffffffffu : 0u;
        f32x4 S0 = (f32x4){0.f, 0.f, 0.f, 0.f}, S1 = S0, S2 = S0, S3 = S0;
        if (sample) { const float* sp = C.in[4] + ((((size_t)l * 8 + b) * 16 + h) * 64 + row) * 64 + 4 * fq;
            S0 = *(const f32x4*)sp; S1 = *(const f32x4*)(sp + 16); S2 = *(const f32x4*)(sp + 32); S3 = *(const f32x4*)(sp + 48); }
        const int asel = ((rowl & 3) == 0 ? 0 : 1024) + 4 * fq;
        __syncthreads();
        __syncthreads();
        for (int c = 0; c < NC; ++c) {
            const LAS float* Mb = (const LAS float*)(L + RW_MAIN + (c & 1) * RW_MSTR);
            const LAS float* Wp = Mb + 2048 + 4 * fq;
            const LAS unsigned* BKp = (const LAS unsigned*)(Mb + 4096) + rowl;
            const LAS bf16* Ap = (const LAS bf16*)(Mb + 3072) + asel;
            const LAS float* Vb = (const LAS float*)(L + RW_POST + (c % 3) * 8320 + 4096) + row;
            LAS float* Yb = (LAS float*)(L + RW_YC + (c & 1) * 4096) + row;
#define RW_LD(t_, W0, W1, W2, W3, K0, K1, K2, K3, A00, A01, A10, A11, VV, SC) do { const int o_ = (t_) * 64; \
                W0 = *(const LAS f32x4*)(Wp + o_); W1 = *(const LAS f32x4*)(Wp + o_ + 16); W2 = *(const LAS f32x4*)(Wp + o_ + 32); W3 = *(const LAS f32x4*)(Wp + o_ + 48); \
                K0 = BKp[o_]; K1 = BKp[o_ + 16]; K2 = BKp[o_ + 32]; K3 = BKp[o_ + 48]; \
                A00 = *(const LAS v2u*)(Ap + o_); A01 = *(const LAS v2u*)(Ap + o_ + 16); A10 = *(const LAS v2u*)(Ap + o_ + 32); A11 = *(const LAS v2u*)(Ap + o_ + 48); \
                VV = Vb[o_]; SC = *(const LAS f32x2*)(Mb + 5120 + (t_) * 2); } while (0)
            f32x4 w_0, w_1, w_2, w_3; unsigned k_0, k_1, k_2, k_3; v2u a00, a01, a10, a11; float vv; f32x2 sc;
            RW_LD(0, w_0, w_1, w_2, w_3, k_0, k_1, k_2, k_3, a00, a01, a10, a11, vv, sc);
#pragma unroll 2
            for (int t = 0; t < 16; ++t) {
                const int tn = t < 15 ? t + 1 : 15;
                f32x4 nw_0, nw_1, nw_2, nw_3; unsigned nk_0, nk_1, nk_2, nk_3; v2u na00, na01, na10, na11; float nvv; f32x2 nsc;
                RW_LD(tn, nw_0, nw_1, nw_2, nw_3, nk_0, nk_1, nk_2, nk_3, na00, na01, na10, na11, nvv, nsc);
                v4u sb0, sb1; sb0.x = pk2c(S0.x, S0.y); sb0.y = pk2c(S0.z, S0.w); sb0.z = pk2c(S1.x, S1.y); sb0.w = pk2c(S1.z, S1.w);
                sb1.x = pk2c(S2.x, S2.y); sb1.y = pk2c(S2.z, S2.w); sb1.z = pk2c(S3.x, S3.y); sb1.w = pk2c(S3.z, S3.w);
                const v4u af0 = (v4u){a00.x, a00.y, a01.x, a01.y}, af1 = (v4u){a10.x, a10.y, a11.x, a11.y};
                f32x4 d = __builtin_amdgcn_mfma_f32_16x16x32_bf16(__builtin_bit_cast(bf16x8, af0), __builtin_bit_cast(bf16x8, sb0), (f32x4){0.f, 0.f, 0.f, 0.f}, 0, 0, 0);
                d = __builtin_amdgcn_mfma_f32_16x16x32_bf16(__builtin_bit_cast(bf16x8, af1), __builtin_bit_cast(bf16x8, sb1), d, 0, 0, 0);
                const float sa = d.x; const float y = d.y + sa * sc.x + vv * sc.y;
                const bf16x8 bu = __builtin_bit_cast(bf16x8, (v4u){pk2c(sa, vv) & m0, 0u, 0u, 0u});
                S0 = __builtin_amdgcn_mfma_f32_16x16x32_bf16(__builtin_bit_cast(bf16x8, (v4u){k_0 & m0, 0u, 0u, 0u}), bu, S0 * w_0, 0, 0, 0);
                S1 = __builtin_amdgcn_mfma_f32_16x16x32_bf16(__builtin_bit_cast(bf16x8, (v4u){k_1 & m0, 0u, 0u, 0u}), bu, S1 * w_1, 0, 0, 0);
                S2 = __builtin_amdgcn_mfma_f32_16x16x32_bf16(__builtin_bit_cast(bf16x8, (v4u){k_2 & m0, 0u, 0u, 0u}), bu, S2 * w_2, 0, 0, 0);
                S3 = __builtin_amdgcn_mfma_f32_16x16x32_bf16(__builtin_bit_cast(bf16x8, (v4u){k_3 & m0, 0u, 0u, 0u}), bu, S3 * w_3, 0, 0, 0);
                if (fq == 0) Yb[t * 64] = y;
                w_0 = nw_0; w_1 = nw_1; w_2 = nw_2; w_3 = nw_3; k_0 = nk_0; k_1 = nk_1; k_2 = nk_2; k_3 = nk_3; a00 = na00; a01 = na01; a10 = na10; a11 = na11; vv = nvv; sc = nsc;
            }
#undef RW_LD
            __syncthreads();
        }
        float* so = C.out + (sample ? O_WKVS : O_WKVP) + ((((size_t)l * 8 + b) * 16 + h) * 64 + row) * 64 + 4 * fq;
        *(f32x4*)so = S0; *(f32x4*)(so + 16) = S1; *(f32x4*)(so + 32) = S2; *(f32x4*)(so + 48) = S3;
    } else {
        const int pw = w - 4, tl = lane >> 4, sub = lane & 15, ch0 = 4 * sub, fr = lane & 15, fq = lane >> 4;
        LAS bf16* XLw = (LAS bf16*)(L + RW_XL + pw * 2176);
        LAS float* ZR = (LAS float*)(L + RW_ZR + pw * 3072);
        LAS bf16* LW0 = (LAS bf16*)(L + RW_LW); LAS bf16* LW1 = LW0 + 64 * 72; LAS bf16* LW2 = LW1 + 64 * 72;
        { const int pt = pw * 64 + lane;
          for (int i = pt; i < 64 * 8; i += 256) { const int n = i >> 3, kc = i & 7;
              *(LAS v4u*)(LW0 + n * 72 + kc * 8) = *(const v4u*)((const bf16*)(C.ws + WS_W2T) + (size_t)(h * 64 + n) * 64 + kc * 8);
              *(LAS v4u*)(LW1 + n * 72 + kc * 8) = *(const v4u*)((const bf16*)(C.ws + WS_A2T) + (size_t)(h * 64 + n) * 64 + kc * 8); }
          for (int i = pt; i < 64 * 16; i += 256) { const int n = i >> 4, kc = i & 15;
              *(LAS v4u*)(LW2 + n * 136 + kc * 8) = *(const v4u*)((const bf16*)(C.ws + WS_G2T) + (size_t)(h * 64 + n) * 128 + kc * 8); } }
        const int gc = h * 64 + ch0;
        const f32x4 cw0 = *(const f32x4*)(C.in[14] + (size_t)l * DM + gc), ca0 = *(const f32x4*)(C.in[16] + (size_t)l * DM + gc), ckk = *(const f32x4*)(C.in[19] + (size_t)l * DM + gc),
                    cka = *(const f32x4*)(C.in[20] + (size_t)l * DM + gc), crk = *(const f32x4*)(C.in[21] + (size_t)l * DM + gc), clg = *(const f32x4*)(C.in[22] + (size_t)l * DM + gc),
                    clb = *(const f32x4*)(C.in[23] + (size_t)l * DM + gc);
        LAS float* MU = (LAS float*)(L + RW_MU);
        { const float* mu = C.in[13] + (size_t)l * RC; const int pt = pw * 64 + lane;
          for (int i = pt; i < 448; i += 256) { const int q = i >> 3, e = i & 7; const int col = q < 8 ? h * 64 + q * 8 : q < 16 ? 1024 + h * 64 + (q - 8) * 8 : q < 24 ? 2048 + h * 64 + (q - 16) * 8 : 3072 + (q - 24) * 8; MU[i] = mu[col + e]; MU[448 + i] = sample ? C.in[5][((size_t)l * 8 + b) * RC + col + e] : 0.f; } }
        RawRegs rA, rB;
        const bf16* PRu = PR + rowbase * RC;
        int ioff[4], itl[4], iq[4];
        { itl[0] = lane / 24; iq[0] = lane % 24;
          if (lane < 32) { itl[1] = (64 + lane) / 24; iq[1] = (64 + lane) % 24; } else { itl[1] = (lane - 32) >> 3; iq[1] = 32 + ((lane - 32) & 7); }
          itl[2] = (lane & 31) >> 3; iq[2] = 24 + (lane & 7);
          itl[3] = lane >> 4; iq[3] = 40 + (lane & 15);
#pragma unroll
          for (int j = 0; j < 4; ++j) { const int q = iq[j]; const int col = q < 8 ? h * 64 + q * 8 : q < 16 ? 1024 + h * 64 + (q - 8) * 8 : q < 24 ? 2048 + h * 64 + (q - 16) * 8 : 3072 + (q - 24) * 8;
              ioff[j] = (4 * pw + itl[j]) * RC + col; } }
        rw_issue(rA, PRu, T, 0, pw, ioff, itl);
        __syncthreads();
#define RW_BODY(c, rcur, FIRST) do { \
            if ((c) >= 1) { const int cp = (c) - 1, tok = 4 * pw + tl; \
                const f32x4 y = *(const LAS f32x4*)(L + RW_YC + (cp & 1) * 4096 + (tok * 64 + ch0) * 4); \
                const LAS unsigned char* Pb = L + RW_POST + (cp % 3) * 8320; \
                const f32x4 g = *(const LAS f32x4*)(Pb + (tok * 64 + ch0) * 4), v = *(const LAS f32x4*)(Pb + 4096 + (tok * 64 + ch0) * 4); const float bon = *(const LAS float*)(Pb + 8192 + tok * 4); \
                const float mean = row16_sum((y.x + y.y) + (y.z + y.w)) * (1.f / 64.f); const f32x4 d = y - mean; \
                const float var = row16_sum((d.x * d.x + d.y * d.y) + (d.z * d.z + d.w * d.w)) * (1.f / 64.f); const float rstd = __builtin_amdgcn_rsqf(var + 64e-5f); \
                const f32x4 o = (d * rstd * clg + clb + v * bon) * g; \
                v2u ow; ow.x = pk2(o.x, o.y); ow.y = pk2(o.z, o.w); \
                *(v2u*)(Yg + (rowbase + cp * 16 + tok) * DM + gc) = ow; } \
            const int cn = (c) + 1; \
            if (cn < NC) { \
                LAS float* Mb = (LAS float*)(L + RW_MAIN + (cn & 1) * RW_MSTR); LAS float* Pf = (LAS float*)(L + RW_POST + (cn % 3) * 8320); \
_Pragma("unroll") \
                for (int j = 0; j < 4; ++j) { const int t4 = itl[j], q = iq[j]; const int t = cn * 16 + 4 * pw + t4; \
                    { const int col = q < 8 ? h * 64 + q * 8 : q < 16 ? 1024 + h * 64 + (q - 8) * 8 : q < 24 ? 2048 + h * 64 + (q - 16) * 8 : 3072 + (q - 24) * 8; \
                        float cur[8], prv[8]; unpack8(rcur.cur[j], cur); unpack8(rcur.prv[j], prv); \
                        if (FIRST && t == 0) { const f32x4 x0 = *(const LAS f32x4*)(MU + 448 + q * 8), x1 = *(const LAS f32x4*)(MU + 452 + q * 8); \
                            prv[0] = x0.x; prv[1] = x0.y; prv[2] = x0.z; prv[3] = x0.w; prv[4] = x1.x; prv[5] = x1.y; prv[6] = x1.z; prv[7] = x1.w; } \
                        const f32x4 m0 = *(const LAS f32x4*)(MU + q * 8), m1 = *(const LAS f32x4*)(MU + q * 8 + 4); \
                        const float mm[8] = {m0.x, m0.y, m0.z, m0.w, m1.x, m1.y, m1.z, m1.w}; float mx[8]; \
_Pragma("unroll") \
                        for (int e = 0; e < 8; ++e) mx[e] = cur[e] + (prv[e] - cur[e]) * mm[e]; \
                        const int tok = 4 * pw + t4; \
                        if (q < 24) { LAS float* dst = (q < 8 ? Mb : q < 16 ? Mb + 1024 : Pf + 1024) + tok * 64 + (q & 7) * 8; \
                            *(LAS f32x4*)dst = (f32x4){mx[0], mx[1], mx[2], mx[3]}; *(LAS f32x4*)(dst + 4) = (f32x4){mx[4], mx[5], mx[6], mx[7]}; } \
                        else { float o[8]; \
                            if (q < 32) { \
_Pragma("unroll") \
                                for (int e = 0; e < 8; ++e) { const float ex = __expf(2.0f * mx[e]); o[e] = 1.0f - 2.0f * __builtin_amdgcn_rcpf(ex + 1.0f); } } \
                            else if (q < 40) { \
_Pragma("unroll") \
                                for (int e = 0; e < 8; ++e) o[e] = mx[e]; } \
                            else { \
_Pragma("unroll") \
                                for (int e = 0; e < 8; ++e) o[e] = pg8::fast_sigmoid(mx[e]); } \
                            *(LAS v4u*)(XLw + t4 * 264 + (q - 24) * 8) = pack8(o); } } } \
                asm volatile("" ::: "memory"); \
_Pragma("unroll") \
                for (int mat = 0; mat < 3; ++mat) { const int KK = mat == 2 ? 128 : 64, xoff = mat * 64, st = mat == 2 ? 136 : 72; const LAS bf16* LWm = mat == 0 ? LW0 : mat == 1 ? LW1 : LW2; \
_Pragma("unroll") \
                    for (int nt = 0; nt < 4; ++nt) { f32x4 acc = (f32x4){0.f, 0.f, 0.f, 0.f}; \
_Pragma("unroll") \
                        for (int k2 = 0; k2 < KK / 32; ++k2) { const bf16x8 wf = *(const LAS bf16x8*)(LWm + (nt * 16 + fr) * st + k2 * 32 + fq * 8); \
                            const bf16x8 xf = *(const LAS bf16x8*)(XLw + (fr & 3) * 264 + xoff + k2 * 32 + fq * 8); \
                            acc = __builtin_amdgcn_mfma_f32_16x16x32_bf16(wf, xf, acc, 0, 0, 0); } \
                        if (fr < 4) *(LAS f32x4*)(ZR + mat * 256 + fr * 64 + nt * 16 + 4 * fq) = acc; } } \
                asm volatile("" ::: "memory"); \
                { const int tok = 4 * pw + tl; \
                  const f32x4 z = *(const LAS f32x4*)(ZR + tl * 64 + ch0), ar = *(const LAS f32x4*)(ZR + 256 + tl * 64 + ch0), g = *(const LAS f32x4*)(ZR + 512 + tl * 64 + ch0); \
                  const f32x4 k = *(const LAS f32x4*)(Mb + 1024 + tok * 64 + ch0), r = *(const LAS f32x4*)(Mb + tok * 64 + ch0); \
                  f32x4 wd, a; \
_Pragma("unroll") \
                  for (int e = 0; e < 4; ++e) { wd[e] = __expf(-0.60653066f * pg8::fast_sigmoid(cw0[e] + z[e])); a[e] = pg8::fast_sigmoid(ca0[e] + ar[e]); } \
                  const f32x4 kk = k * ckk; const float ss = row16_sum((kk.x * kk.x + kk.y * kk.y) + (kk.z * kk.z + kk.w * kk.w)); \
                  const float inv = __builtin_amdgcn_rsqf(fmaxf(ss, 1e-24f)); const f32x4 kn = kk * inv; const f32x4 kp = k * (1.0f + (a - 1.0f) * cka); \
                  const f32x4 rb = r * kp * crk; const float bon = row16_sum((rb.x + rb.y) + (rb.z + rb.w)); \
                  const f32x4 bq = kn * a; const f32x4 t1 = bq * r, t2 = kp * r; const float br = row16_sum((t1.x + t1.y) + (t1.z + t1.w)), kr = row16_sum((t2.x + t2.y) + (t2.z + t2.w)); *(LAS f32x4*)(Mb + tok * 64 + ch0) = wd * r; if (sub == 0) *(LAS f32x2*)(Mb + 5120 + tok * 2) = (f32x2){br, kr}; *(LAS f32x4*)(Mb + 2048 + tok * 64 + ch0) = wd; { const f32x4 wr_ = wd * r; LAS bf16* ab = (LAS bf16*)(Mb + 3072); v2u pa, pq; pa.x = pk2(-kn.x, -kn.y); pa.y = pk2(-kn.z, -kn.w); pq.x = pk2(wr_.x, wr_.y); pq.y = pk2(wr_.z, wr_.w); *(LAS v2u*)(ab + tok * 64 + ch0) = pa; *(LAS v2u*)(ab + 1024 + tok * 64 + ch0) = pq; } *(LAS v4u*)((LAS unsigned*)(Mb + 4096) + tok * 64 + ch0) = (v4u){pk2(bq.x, kp.x), pk2(bq.y, kp.y), pk2(bq.z, kp.z), pk2(bq.w, kp.w)}; \
                  *(LAS f32x4*)(Pf + tok * 64 + ch0) = g; if (sub == 0) Pf[2048 + tok] = bon; } \
            } \
        } while (0)
        rw_issue(rB, PRu, T, 1, pw, ioff, itl);
        RW_BODY(-1, rA, true);
        __syncthreads();
        for (int c2 = 0; c2 < NC; c2 += 2) {
            if (!sample && c2 == 142) {
                if (lane == 0) { unsigned sp = 0; while (__hip_atomic_load((const unsigned*)C.ws + 32, __ATOMIC_RELAXED, __HIP_MEMORY_SCOPE_AGENT) < 128u * (unsigned)(l + 1) && ++sp < (1u << 24)) __builtin_amdgcn_s_sleep(4); }
                __builtin_amdgcn_fence(__ATOMIC_ACQUIRE, "agent"); asm volatile("s_waitcnt vmcnt(0)" ::: "memory"); }
            rw_issue(rA, PRu, T, c2 + 2, pw, ioff, itl);
            RW_BODY(c2, rB, false);
            __syncthreads();
            rw_issue(rB, PRu, T, c2 + 3, pw, ioff, itl);
            RW_BODY(c2 + 1, rA, false);
            __syncthreads();
        }
#undef RW_BODY
        { const int cp = NC - 1, tok = 4 * pw + tl;
          const f32x4 y = *(const LAS f32x4*)(L + RW_YC + (cp & 1) * 4096 + (tok * 64 + ch0) * 4);
          const LAS unsigned char* Pb = L + RW_POST + (cp % 3) * 8320;
          const f32x4 g = *(const LAS f32x4*)(Pb + (tok * 64 + ch0) * 4), v = *(const LAS f32x4*)(Pb + 4096 + (tok * 64 + ch0) * 4); const float bon = *(const LAS float*)(Pb + 8192 + tok * 4);
          const float mean = row16_sum((y.x + y.y) + (y.z + y.w)) * (1.f / 64.f); const f32x4 d = y - mean;
          const float var = row16_sum((d.x * d.x + d.y * d.y) + (d.z * d.z + d.w * d.w)) * (1.f / 64.f); const float rstd = __builtin_amdgcn_rsqf(var + 64e-5f);
          const f32x4 o = (d * rstd * clg + clb + v * bon) * g;
          v2u ow; ow.x = pk2(o.x, o.y); ow.y = pk2(o.z, o.w);
          *(v2u*)(Yg + (rowbase + cp * 16 + tok) * DM + gc) = ow; }
    }
    __syncthreads();
}
__device__ __forceinline__ void rwkv_phase(const Ctx& C, int l, bool aux, int csub) {
    { const int s = aux ? 1 : 0, r = csub & 127;
      Ctx C2 = C; { int t_ = C.tid; asm volatile("" : "+v"(t_)); C2.tid = t_; C2.lane = t_ & 63; C2.wave = __builtin_amdgcn_readfirstlane(t_ >> 6); }
      rwkv_unit(C2, l, s, r >> 4, r & 15); }
    if (!aux) { const bf16* PR = (const bf16*)(C.ws + WS_BIG);
      for (int i = blockIdx.x * NT + C.tid; i < 16 * RC; i += 128 * NT) { const int bb = i / RC, c = i % RC;
        const size_t row = bb < 8 ? (size_t)bb * SEQ + SEQ - 1 : (size_t)MP + (size_t)(bb - 8) * DECS + DECS - 1;
        const float v = __uint_as_float((unsigned)PR[row * RC + c] << 16);
        C.out[(bb < 8 ? O_SHP : O_SHS) + ((size_t)l * 8 + (bb & 7)) * RC + c] = v; } }
}

__device__ __forceinline__ void sgu_phase(const Ctx& C, int l, int csub, int gsub) {
    const bf16* UV = (const bf16*)(C.ws + WS_UVB); bf16* Yg = (bf16*)(C.ws + WS_UVB); const bf16* WS = (const bf16*)(C.ws + WS_WS);
    const float* lng = C.in[24] + (size_t)l * DM; const float* lnb = C.in[25] + (size_t)l * DM; const float* bs = C.in[27] + (size_t)l * 8 * 128;
    LAS float* stat = (LAS float*)C.lds;
    const int lane = C.lane, w = C.wave, fr = lane & 15, fq = lane >> 4;
    LAS bf16* VT = (LAS bf16*)(C.lds + 1024 + w * 8704);
    for (int u = csub; u < 520; u += gsub) {
        const int sample = u >= 512; const int nrows = sample ? 32 : 128;
        const size_t row0 = sample ? (size_t)MP + (size_t)(u - 512) * DECS : (size_t)u * 128;
        for (int tk = w * 16; tk < w * 16 + 16; ++tk) {
            if (tk < nrows) {
                const bf16* vp = UV + (row0 + tk) * 2048 + 1024 + lane * 16; float x[16];
                unpack8(*(const v4u*)vp, x); unpack8(*(const v4u*)(vp + 8), x + 8);
                float s = 0.f;
#pragma unroll
                for (int e = 0; e < 16; ++e) s += x[e];
                const float mean = wave_sum(s) * (1.f / 1024.f); float q = 0.f;
#pragma unroll
                for (int e = 0; e < 16; ++e) { x[e] -= mean; q += x[e] * x[e]; }
                const float rstd = 1.0f / sqrtf(wave_sum(q) * (1.f / 1024.f) + 1e-5f);
                if (lane == 0) { stat[tk * 2] = mean; stat[tk * 2 + 1] = rstd; }
                if (sample) { float* op = C.out + O_SGUV + (((size_t)l * 8 + (u - 512)) * DECS + tk) * DM + lane * 16;
#pragma unroll
                    for (int e4 = 0; e4 < 4; ++e4) { const f32x4 gg = *(const f32x4*)(lng + lane * 16 + e4 * 4), bb = *(const f32x4*)(lnb + lane * 16 + e4 * 4);
                        f32x4 o; o.x = x[e4 * 4] * rstd * gg.x + bb.x; o.y = x[e4 * 4 + 1] * rstd * gg.y + bb.y; o.z = x[e4 * 4 + 2] * rstd * gg.z + bb.z; o.w = x[e4 * 4 + 3] * rstd * gg.w + bb.w;
                        *(f32x4*)(op + e4 * 4) = o; } }
            }
        }
        __syncthreads();
        const int g = w;
        for (int q4 = 0; q4 < 4; ++q4) {
            const int c0 = g * 128 + q4 * 32;
            { const int cl = lane & 3, jl = lane >> 2; float gg[8], bb[8];
#pragma unroll
              for (int e = 0; e < 8; ++e) { gg[e] = lng[c0 + cl * 8 + e]; bb[e] = lnb[c0 + cl * 8 + e]; }
#pragma unroll
              for (int p = 0; p < 8; ++p) { const int j = p * 16 + jl; float x[8];
                  if (j < nrows) { unpack8(*(const v4u*)(UV + (row0 + j) * 2048 + 1024 + c0 + cl * 8), x); const float mean = stat[j * 2], rstd = stat[j * 2 + 1];
#pragma unroll
                      for (int e = 0; e < 8; ++e) x[e] = (x[e] - mean) * rstd * gg[e] + bb[e]; }
                  else {
#pragma unroll
                      for (int e = 0; e < 8; ++e) x[e] = 0.f; }
#pragma unroll
                  for (int e = 0; e < 8; ++e) VT[(cl * 8 + e) * 136 + j] = (bf16)f2bf(x[e]); } }
            LDS_WAIT(); __builtin_amdgcn_wave_barrier();
            const int nit = nrows / 16;
            for (int it = 0; it < nit; ++it) {
                f32x4 acc0 = (f32x4){0.f, 0.f, 0.f, 0.f}, acc1 = acc0;
                for (int k2 = 0; k2 <= (it >> 1); ++k2) {
                    const bf16x8 wf = *(const bf16x8*)(WS + ((size_t)g * 128 + it * 16 + fr) * 128 + k2 * 32 + fq * 8);
                    const bf16x8 v0 = *(const LAS bf16x8*)(VT + (fr) * 136 + k2 * 32 + fq * 8);
                    const bf16x8 v1 = *(const LAS bf16x8*)(VT + (16 + fr) * 136 + k2 * 32 + fq * 8);
                    acc0 = __builtin_amdgcn_mfma_f32_16x16x32_bf16(v0, wf, acc0, 0, 0, 0);
                    acc1 = __builtin_amdgcn_mfma_f32_16x16x32_bf16(v1, wf, acc1, 0, 0, 0);
                }
                const int i = it * 16 + fr; const float bsi = bs[g * 128 + i];
#pragma unroll
                for (int ct = 0; ct < 2; ++ct) { const f32x4 a = ct ? acc1 : acc0; const int c = c0 + ct * 16 + fq * 4;
                    const v2u uu = *(const v2u*)(UV + (row0 + i) * 2048 + c);
                    v2u o; o.x = pk2(bflo(uu.x) * (a.x + bsi), bfhi(uu.x) * (a.y + bsi)); o.y = pk2(bflo(uu.y) * (a.z + bsi), bfhi(uu.y) * (a.w + bsi));
                    *(v2u*)(Yg + (row0 + i) * 2048 + c) = o; }
            }
            LDS_WAIT(); __builtin_amdgcn_wave_barrier();
        }
        __syncthreads();
    }
}

__device__ __forceinline__ void attn_phase(const Ctx& C, int csub, int gsub) {
    const bf16* Q = (const bf16*)(C.ws + WS_UVB) + 1024; bf16* Yg = (bf16*)(C.ws + WS_UVB) + 1024;
    const bf16* KB = (const bf16*)(C.ws + WS_KB); const bf16* VT = (const bf16*)(C.ws + WS_VT);
    const int lane = C.lane, w = C.wave, fr = lane & 15, fq = lane >> 4, tid = C.tid;
    LAS bf16* KL = (LAS bf16*)C.lds;
    for (int u = csub; u < 1024 + 32; u += gsub) {
        int bb, h, nqt; size_t rowq;
        if (u < 1024) { const int rb = u >> 2; h = u & 3; bb = rb >> 5; rowq = (size_t)rb * 256 + w * 32; nqt = 2; }
        else { const int su = u - 1024; h = su & 3; bb = 8 + (su >> 2); rowq = (size_t)MP + (size_t)(su >> 2) * DECS + w * 16; nqt = w < 2 ? 1 : 0; }
        const bf16* Kp = KB + (size_t)bb * 262144 + h * 256; const bf16* Vp = VT + ((size_t)bb * 4 + h) * 65536;
        __syncthreads();
#pragma unroll 4
        for (int i = tid; i < 8192; i += NT) { const int m = i >> 5, ch = i & 31; *(LAS v4u*)(KL + m * 264 + ch * 8) = *(const v4u*)(Kp + (size_t)m * 1024 + ch * 8); }
        __syncthreads();
        bf16x8 pf[2][8]; float rs[2];
#pragma unroll
        for (int j = 0; j < 2; ++j) {
            rs[j] = 0.f;
#pragma unroll
            for (int k2 = 0; k2 < 8; ++k2) pf[j][k2] = (bf16x8){0, 0, 0, 0, 0, 0, 0, 0};
            if (j < nqt) {
                const size_t row0 = rowq + j * 16;
                bf16x8 qf[8];
#pragma unroll
                for (int k2 = 0; k2 < 8; ++k2) qf[k2] = *(const bf16x8*)(Q + (row0 + fr) * 2048 + h * 256 + k2 * 32 + fq * 8);
                f32x4 s[16];
#pragma unroll
                for (int mt = 0; mt < 16; ++mt) { f32x4 acc = (f32x4){0.f, 0.f, 0.f, 0.f};
#pragma unroll
                    for (int k2 = 0; k2 < 8; ++k2) { const bf16x8 kf = *(const LAS bf16x8*)(KL + (mt * 16 + fr) * 264 + k2 * 32 + fq * 8);
                        acc = __builtin_amdgcn_mfma_f32_16x16x32_bf16(kf, qf[k2], acc, 0, 0, 0); }
                    s[mt] = acc; }
                float mx = -3.0e38f;
#pragma unroll
                for (int mt = 0; mt < 16; ++mt) mx = fmaxf(mx, fmaxf(fmaxf(s[mt].x, s[mt].y), fmaxf(s[mt].z, s[mt].w)));
                mx = fmaxf(mx, __shfl_xor(mx, 16)); mx = fmaxf(mx, __shfl_xor(mx, 32));
                float sum = 0.f;
#pragma unroll
                for (int mt = 0; mt < 16; ++mt) {
#pragma unroll
                    for (int e = 0; e < 4; ++e) { const float p = __expf((s[mt][e] - mx) * 0.0625f); s[mt][e] = p; sum += p; } }
                sum += __shfl_xor(sum, 16); sum += __shfl_xor(sum, 32);
                rs[j] = 1.0f / sum;
#pragma unroll
                for (int k2 = 0; k2 < 8; ++k2) { v4u pw; pw.x = pk2(s[2 * k2].x, s[2 * k2].y); pw.y = pk2(s[2 * k2].z, s[2 * k2].w); pw.z = pk2(s[2 * k2 + 1].x, s[2 * k2 + 1].y); pw.w = pk2(s[2 * k2 + 1].z, s[2 * k2 + 1].w);
                    pf[j][k2] = __builtin_bit_cast(bf16x8, pw); }
            }
        }
        __syncthreads();
#pragma unroll 4
        for (int i = tid; i < 8192; i += NT) { const int d = i >> 5, ch = i & 31; *(LAS v4u*)(KL + d * 264 + ch * 8) = *(const v4u*)(Vp + (size_t)d * 256 + ch * 8); }
        __syncthreads();
#pragma unroll
        for (int j = 0; j < 2; ++j) {
            if (j < nqt) {
                const size_t row0 = rowq + j * 16;
#pragma unroll 2
                for (int dt = 0; dt < 16; ++dt) { f32x4 acc = (f32x4){0.f, 0.f, 0.f, 0.f};
#pragma unroll
                    for (int k2 = 0; k2 < 8; ++k2) { const bf16x8 vf = *(const LAS bf16x8*)(KL + (dt * 16 + fr) * 264 + k2 * 32 + fq * 8);
                        acc = __builtin_amdgcn_mfma_f32_16x16x32_bf16(vf, pf[j][k2], acc, 0, 0, 0); }
                    v2u o; o.x = pk2(acc.x * rs[j], acc.y * rs[j]); o.y = pk2(acc.z * rs[j], acc.w * rs[j]);
                    *(v2u*)(Yg + (row0 + fr) * 2048 + h * 256 + dt * 16 + fq * 4) = o; }
            }
        }
    }
    __syncthreads();
}

__device__ __forceinline__ void final_norm(const Ctx& C) {
    float* X = C.out; const float* g = C.in[10];
    for (int r = C.gw; r < M; r += C.ngw) {
        f32x4* xr = (f32x4*)(X + (size_t)r * DM) + C.lane; const f32x4* gr = (const f32x4*)g + C.lane;
        f32x4 v[4]; float s = 0.f;
#pragma unroll
        for (int j = 0; j < 4; ++j) { v[j] = xr[64 * j]; s += (v[j].x * v[j].x + v[j].y * v[j].y) + (v[j].z * v[j].z + v[j].w * v[j].w); }
        const float rr = 1.0f / sqrtf(wave_sum(s) * (1.f / DM) + 1e-6f);
#pragma unroll
        for (int j = 0; j < 4; ++j) xr[64 * j] = v[j] * rr * gr[64 * j];
    }
}

__device__ __forceinline__ void small_gemm(const Ctx& C, int csub, int gsub, const bf16* A, int lda, const bf16* Bt, int N, int K, int mode, bf16* O, const bf16* T, float* X, int ldc, int first) {
    const int lane = C.lane, w = C.wave, fr = lane & 15, fq = lane >> 4;
    const int nit = 8 * (N >> 6);
    for (int it = csub; it < nit; it += gsub) {
        const int rg = it & 7, cg = it >> 3;
        const size_t row = (size_t)MP + rg * 32 + (w & 1) * 16 + fr; const int colb = cg * 64 + (w >> 1) * 16;
        const bf16* ap = A + row * lda + fq * 8; const bf16* bp = Bt + (size_t)(colb + fr) * K + fq * 8;
        f32x4 acc = (f32x4){0.f, 0.f, 0.f, 0.f};
#pragma unroll 16
        for (int k2 = 0; k2 < (K >> 5); ++k2) { const bf16x8 af = *(const bf16x8*)(ap + k2 * 32), bf = *(const bf16x8*)(bp + k2 * 32);
            acc = __builtin_amdgcn_mfma_f32_16x16x32_bf16(bf, af, acc, 0, 0, 0); }
        const size_t off = row * ldc + colb + 4 * fq;
        if (mode == 4) { f32x4* p = (f32x4*)(X + off); *p = *p + acc; }
        else { f32x4 v = acc;
            if (mode == 1) {
#pragma unroll
                for (int e = 0; e < 4; ++e) v[e] = pg8::gelu_tanh(v[e]); }
            else if (mode == 2) {
#pragma unroll
                for (int e = 0; e < 4; ++e) { const float r = fmaxf(v[e], 0.f); v[e] = r * r; } }
            else if (mode == 3) { const v2u t = *(const v2u*)(T + off); v2u g = (v2u){0u, 0u}; if (!first) g = *(const v2u*)(O + off);
                v[0] = bflo(g.x) + pg8::fast_sigmoid(v[0]) * bflo(t.x); v[1] = bfhi(g.x) + pg8::fast_sigmoid(v[1]) * bfhi(t.x);
                v[2] = bflo(g.y) + pg8::fast_sigmoid(v[2]) * bflo(t.y); v[3] = bfhi(g.y) + pg8::fast_sigmoid(v[3]) * bfhi(t.y); }
            v2u o; o.x = pk2(v[0], v[1]); o.y = pk2(v[2], v[3]); *(v2u*)(O + off) = o; }
    }
}

#ifndef PH_LO
#define PH_LO 0
#endif
#ifndef PH_HI
#define PH_HI 1000
#endif
__global__ void __launch_bounds__(NT, 2) mega_fwd(Args args) {
    extern __shared__ __attribute__((aligned(16))) unsigned char lds_raw[];
    cg::grid_group grid = cg::this_grid();
    const int G = gridDim.x, cb = blockIdx.x;
    typedef pg8::bf16_t pb;
    constexpr int NSTEP = 2 + 16 * DEPTH + 1;
    const bool aux = blockIdx.x >= 128; const int csub = aux ? (int)blockIdx.x - 128 : (int)blockIdx.x;
    unsigned* const subcnt = (unsigned*)args.ws;
    int nbar = 0;
    bool second = false;
    for (int step = PH_LO; step < NSTEP && step < PH_HI; ++step) {
        Ctx C; { int z_ = 0, t_ = threadIdx.x; asm volatile("" : "+s"(z_), "+v"(t_));
                 C.in = args.in + z_; C.out = args.out + z_; C.ws = args.ws + z_; C.lds = (LAS unsigned char*)lds_raw; C.tid = t_; C.lane = t_ & 63; C.wave = __builtin_amdgcn_readfirstlane(t_ >> 6);
                 C.gw = blockIdx.x * NWAVES + C.wave; C.ngw = gridDim.x * NWAVES; }
        int l = 0, ls = -1;
        if (step >= 2 && step < 2 + 16 * DEPTH) { l = (step - 2) / 16; ls = (step - 2) % 16; }
        int gm = -1, gN = 0, gK = DM, gM = MP, ldc = 0, lda = DM, first = 0, memkv = 0, gG = G, gc = cb, half = 0; size_t aoff = 0, boff = 0, ooff = 0, toff = 0; bool sync = true;
        if (step == 1) { gm = 5; gM = 8192; gN = 8192; aoff = WS_AMEM; boff = WS_WMKV; memkv = 1; }
        switch (ls) {
            case 1: gm = 0; gN = RC; aoff = WS_H; boff = WS_WIN; ooff = WS_BIG; ldc = RC; gM = 8 * 9 * 256; half = 1; break;
            case 2: if (aux) { gG = 128; gc = csub;
                        if (!second) { gm = 0; gN = RC; aoff = WS_H; boff = WS_WIN; ooff = WS_BIG; ldc = RC; gM = 8 * 23 * 256; half = 2; }
                        else { gm = 1; gN = 2048; aoff = WS_H; boff = WS_WIN + (size_t)COL_GMLP * DM * 2; ooff = WS_UVB; ldc = 2048; } } sync = false; break;
            case 3: sync = false; break;
            case 4: if (aux) { gm = 0; gN = DM; aoff = WS_H; boff = WS_WIN + (size_t)COL_Q * DM * 2; ooff = WS_UVB + 2048; ldc = 2048; gG = 128; gc = csub; } sync = false; break;
            case 6: gm = 0; gN = DM; aoff = WS_Y; boff = WS_WB; ooff = WS_T2; ldc = DM; sync = false; break;
            case 7: gm = 3; gN = DM; aoff = WS_H; boff = WS_WIN + (size_t)COL_GATE * DM * 2; ooff = WS_MG2; toff = WS_T2; ldc = DM; first = 1; sync = false; break;
            case 8: gm = 0; gN = DM; aoff = WS_UVB; lda = 2048; boff = WS_WB + (size_t)DM * DM * 2; ooff = WS_T2; ldc = DM; sync = false; break;
            case 9: gm = 3; gN = DM; aoff = WS_H; boff = WS_WIN + (size_t)(COL_GATE + DM) * DM * 2; ooff = WS_MG2; toff = WS_T2; ldc = DM; sync = false; break;
            case 10: gm = 0; gN = DM; aoff = WS_UVB + 2048; lda = 2048; boff = WS_WB + 2 * (size_t)DM * DM * 2; ooff = WS_T2; ldc = DM; sync = false; break;
            case 11: gm = 3; gN = DM; aoff = WS_H; boff = WS_WIN + (size_t)(COL_GATE + 2 * DM) * DM * 2; ooff = WS_MG2; toff = WS_T2; ldc = DM; break;
            case 12: gm = 4; gN = DM; aoff = WS_MG2; boff = WS_WOUT; ldc = DM; break;
            case 14: gm = 2; gN = DFF; aoff = WS_H; boff = WS_WUP; ooff = WS_UP; ldc = DFF; break;
            case 15: gm = 4; gN = DM; gK = DFF; lda = DFF; aoff = WS_UP; boff = WS_WDN; ldc = DM; break;
            default: break;
        }
        if (gm >= 0) {
            pg8::Gemm g_{(const pb*)(C.ws + aoff), (const pb*)(C.ws + boff), gM, gN, gK, lda};
            pg8::OrderU S_; S_.so.init(gM, gN, gG, gc); S_.memkv = memkv; S_.half = half;
            pg8::EpiU E_{gm, gm <= 3, (pb*)(C.ws + ooff), (const pb*)(C.ws + toff), gm == 5 ? C.out + O_MK : C.out, C.out + O_MV, ldc, first};
            pg8::gemm_phase<pg8::EpiU, pg8::OrderU, true, true>(C.lds, g_, S_, E_);
            if (half == 2) {
                asm volatile("s_waitcnt vmcnt(0)" ::: "memory"); __syncthreads();
                if (threadIdx.x == 0) { __builtin_amdgcn_fence(__ATOMIC_RELEASE, "agent"); asm volatile("s_waitcnt vmcnt(0)" ::: "memory"); __hip_atomic_fetch_add(subcnt + 32, 1u, __ATOMIC_RELAXED, __HIP_MEMORY_SCOPE_AGENT); }
            } else if (!memkv) small_gemm(C, gc, gG, (const bf16*)(C.ws + aoff), lda, (const bf16*)(C.ws + boff), gN, gK, gm, (bf16*)(C.ws + ooff), (const bf16*)(C.ws + toff), C.out, ldc, first);
        }
        else if (step == 0 || ls == 0 || ls == 13) prep_phase(C, step == 0 ? -1 : ls == 0 ? l : -2, l);
        else if (step == NSTEP - 1) { final_norm(C); sync = false; }
        else if ((ls == 2 && !aux) || (ls == 3 && aux)) { rwkv_phase(C, l, aux, csub); if (aux) sgu_phase(C, l, csub, 128); }
        else if (ls == 5 && aux) attn_phase(C, csub, 128);
        if (aux && ls == 2 && !second) { second = true; --step; continue; }
        second = false;
        if (aux && ls >= 2 && ls <= 4) sub_barrier(subcnt, 128u * (unsigned)(l * 3 + (ls - 1)), 0, ls == 2 ? subcnt + 64 : nullptr, (unsigned)G * (unsigned)nbar);
        if (sync) { if (step == 0) grid.sync();
                    else sub_barrier(subcnt + 64, (unsigned)G * (unsigned)(++nbar), (ls == 1 && aux) ? 1 : 0); }
    }
}

extern "C" void kernel_launch(void* const* d_in, const int* in_sizes, int n_in, void* d_out, int out_size, void* d_ws, size_t ws_size, hipStream_t stream) {
    static int grid = 0;
    if (grid == 0) {
        if (n_in != 32 || (size_t)out_size != O_END || ws_size < WS_END) { fprintf(stderr, "kernel_launch: unexpected shapes n_in %d out %d ws %zu (need %zu)\n", n_in, out_size, ws_size, (size_t)WS_END); grid = -1; return; }
        int dev = 0, cus = 0, per_cu = 0;
        hipGetDevice(&dev); hipDeviceGetAttribute(&cus, hipDeviceAttributeMultiprocessorCount, dev);
        hipFuncSetAttribute((const void*)mega_fwd, hipFuncAttributeMaxDynamicSharedMemorySize, LDS_BYTES);
        hipOccupancyMaxActiveBlocksPerMultiprocessor(&per_cu, (const void*)mega_fwd, NT, LDS_BYTES);
        (void)hipGetLastError();
        if (per_cu < 1) per_cu = 1;
        grid = 256;
        if (cus < 256) { fprintf(stderr, "kernel_launch: needs 256 CUs, device has %d\n", cus); grid = -1; return; }
    }
    if (grid < 0) return;
    (void)hipMemsetAsync(d_ws, 0, 512, stream);
    Args a{};
    for (int i = 0; i < 32; ++i) a.in[i] = (const float*)d_in[i];
    a.out = (float*)d_out; a.ws = (unsigned char*)d_ws;
    void* params[] = {&a};
    hipError_t e = hipLaunchCooperativeKernel((const void*)mega_fwd, dim3(grid), dim3(NT), params, LDS_BYTES, stream);
    if (e != hipSuccess) fprintf(stderr, "cooperative launch failed: %s (grid %d)\n", hipGetErrorString(e), grid);
}
```

```cpp
#include <hip/hip_runtime.h>
#include <hip/hip_cooperative_groups.h>
#include <cstdio>
#include <cstdint>
namespace cg = cooperative_groups;
namespace pg8 {
#define PG8_LAS __attribute__((address_space(3)))
typedef unsigned short bf16_t;
typedef short bf16x8 __attribute__((ext_vector_type(8)));
typedef float f32x4 __attribute__((ext_vector_type(4)));
typedef unsigned u32x4 __attribute__((ext_vector_type(4)));
constexpr int BM = 256, BK = 64, HALF = 128, HTB = HALF * BK * 2  , STAGE_BYTES = 8 * HTB, NXCD = 8, WGM = 8;

__host__ __device__ __forceinline__ int lds_byte(int r, int c) { const int st = (r >> 4) * 2 + (c >> 5), rr = r & 15, cc = c & 31, ob = rr * 64 + cc * 2; return st * 1024 + (ob ^ (((ob >> 9) & 1) << 5)); }
__host__ __device__ __forceinline__ void stage_rc(int b, int& R, int& C) { const int st = b / 1024, sb = b % 1024, swz = sb ^ (((sb >> 9) & 1) << 5); R = (st >> 1) * 16 + swz / 64; C = (st & 1) * 32 + (swz % 64) / 2; }
__host__ __device__ __forceinline__ int perm32(int rho) { const int n = rho >> 4, i = rho & 15; return 8 * (i >> 2) + 4 * n + (i & 3); }

struct Unit { int pm, pn; };
struct Gemm { const bf16_t* A; const bf16_t* Bt; int M, N, K, lda; };

struct StaticOrder {
    int nM, nN, nwg, G, c;
    __host__ __device__ void init(int M, int N, int G_, int c_) { nM = M / BM; nN = N / BM; nwg = nM * nN; G = G_; c = c_; }
    __host__ __device__ bool next(int i, Unit& u) const {
        const long L = (long)i * G + c; if (L >= nwg) return false;
        int wgid = (int)L; { const int q = nwg / NXCD, r = nwg % NXCD, xcd = wgid % NXCD, off = wgid / NXCD; wgid = (xcd < r ? xcd * (q + 1) : r * (q + 1) + (xcd - r) * q) + off; }
        const int nig = WGM * nN, gid = wgid / nig, fm = gid * WGM, gsz = (nM - fm) < WGM ? (nM - fm) : WGM;
        u.pm = fm + ((wgid % nig) % gsz); u.pn = (wgid % nig) / gsz; return true;
    }
    __device__ __forceinline__ void a_ready(const Unit&) const {}
    __device__ __forceinline__ void done(const Unit&) const {}
};

__device__ __forceinline__ unsigned cvt_pk_bf16(float lo, float hi) { unsigned r; asm volatile("v_cvt_pk_bf16_f32 %0, %1, %2" : "=v"(r) : "v"(lo), "v"(hi)); return r; }
typedef float f32x2 __attribute__((ext_vector_type(2)));
__device__ __forceinline__ float fast_sigmoid(float x) { return __builtin_amdgcn_rcpf(1.0f + __expf(-x)); }
__device__ __forceinline__ float gelu_tanh(float x) { const float z = 1.5957691216f * (x + 0.044715f * x * x * x); return x * fast_sigmoid(z); }
__device__ __forceinline__ float bf_lo(unsigned w) { return __uint_as_float(w << 16); }
__device__ __forceinline__ float bf_hi(unsigned w) { return __uint_as_float(w & 0xffff0000u); }

template <int MODE> struct EpiAct {
    static constexpr bool PERM = true, AFTER_DRAIN = false;
    bf16_t* O; int ldc;
    __device__ __forceinline__ void operator()(const f32x4 (&acc)[2][2][4][2], const Unit& u, int wr, int wc, int fr, int fq) const {
        const int row0 = u.pm * BM + wr * 64 + fr; const int col0 = u.pn * BM + wc * 32 + 8 * fq;
#pragma unroll
        for (int ai = 0; ai < 2; ++ai)
#pragma unroll
            for (int m = 0; m < 4; ++m) { bf16_t* rowp = O + (size_t)(row0 + ai * HALF + m * 16) * ldc + col0;
#pragma unroll
                for (int bj = 0; bj < 2; ++bj) { f32x4 v0 = acc[ai][bj][m][0], v1 = acc[ai][bj][m][1];
                    if (MODE == 1) {
#pragma unroll
                        for (int e = 0; e < 4; ++e) { v0[e] = gelu_tanh(v0[e]); v1[e] = gelu_tanh(v1[e]); } }
                    if (MODE == 2) {
#pragma unroll
                        for (int e = 0; e < 4; ++e) { float a = fmaxf(v0[e], 0.f), b = fmaxf(v1[e], 0.f); v0[e] = a * a; v1[e] = b * b; } }
                    u32x4 w; w.x = cvt_pk_bf16(v0[0], v0[1]); w.y = cvt_pk_bf16(v0[2], v0[3]); w.z = cvt_pk_bf16(v1[0], v1[1]); w.w = cvt_pk_bf16(v1[2], v1[3]);
                    *(u32x4*)(rowp + bj * HALF) = w; } }
    }
};
struct EpiGate {
    static constexpr bool PERM = true, AFTER_DRAIN = false;
    const bf16_t* T; bf16_t* MG; int ldc; int first;
    __device__ __forceinline__ void operator()(const f32x4 (&acc)[2][2][4][2], const Unit& u, int wr, int wc, int fr, int fq) const {
        const int row0 = u.pm * BM + wr * 64 + fr; const int col0 = u.pn * BM + wc * 32 + 8 * fq;
#pragma unroll
        for (int ai = 0; ai < 2; ++ai)
#pragma unroll
            for (int m = 0; m < 4; ++m) { const size_t off = (size_t)(row0 + ai * HALF + m * 16) * ldc + col0;
#pragma unroll
                for (int bj = 0; bj < 2; ++bj) { const f32x4 v0 = acc[ai][bj][m][0], v1 = acc[ai][bj][m][1];
                    const u32x4 t = *(const u32x4*)(T + off + bj * HALF);
                    u32x4 g = (u32x4){0u, 0u, 0u, 0u}; if (!first) g = *(const u32x4*)(MG + off + bj * HALF);
                    float o[8];
                    o[0] = bf_lo(g.x) + fast_sigmoid(v0[0]) * bf_lo(t.x); o[1] = bf_hi(g.x) + fast_sigmoid(v0[1]) * bf_hi(t.x);
                    o[2] = bf_lo(g.y) + fast_sigmoid(v0[2]) * bf_lo(t.y); o[3] = bf_hi(g.y) + fast_sigmoid(v0[3]) * bf_hi(t.y);
                    o[4] = bf_lo(g.z) + fast_sigmoid(v1[0]) * bf_lo(t.z); o[5] = bf_hi(g.z) + fast_sigmoid(v1[1]) * bf_hi(t.z);
                    o[6] = bf_lo(g.w) + fast_sigmoid(v1[2]) * bf_lo(t.w); o[7] = bf_hi(g.w) + fast_sigmoid(v1[3]) * bf_hi(t.w);
                    u32x4 w; w.x = cvt_pk_bf16(o[0], o[1]); w.y = cvt_pk_bf16(o[2], o[3]); w.z = cvt_pk_bf16(o[4], o[5]); w.w = cvt_pk_bf16(o[6], o[7]);
                    *(u32x4*)(MG + off + bj * HALF) = w; } }
    }
};
struct EpiResid {
    static constexpr bool PERM = false, AFTER_DRAIN = false;
    float* X; int ldc;
    __device__ __forceinline__ void operator()(const f32x4 (&acc)[2][2][4][2], const Unit& u, int wr, int wc, int fr, int fq) const {
        const int row0 = u.pm * BM + wr * 64 + fr; const int col0 = u.pn * BM + wc * 32 + 4 * fq;
#pragma unroll
        for (int ai = 0; ai < 2; ++ai)
#pragma unroll
            for (int m = 0; m < 4; ++m) { float* rowp = X + (size_t)(row0 + ai * HALF + m * 16) * ldc + col0;
#pragma unroll
                for (int bj = 0; bj < 2; ++bj)
#pragma unroll
                    for (int n = 0; n < 2; ++n) { f32x4* p = (f32x4*)(rowp + bj * HALF + n * 16); const f32x4 x = *p; *p = x + acc[ai][bj][m][n]; } }
    }
};
struct EpiMemKV {
    static constexpr bool PERM = false, AFTER_DRAIN = false;
    float* mk; float* mv;
    __device__ __forceinline__ void operator()(const f32x4 (&acc)[2][2][4][2], const Unit& u, int wr, int wc, int fr, int fq) const {
        const int l = u.pm >> 3; const int row0 = (u.pm & 7) * BM + wr * 64 + fr; int colt = (u.pn & 7) * BM;
        float* base = mk + (colt < 1024 ? (size_t)0 : (size_t)(mv - mk)) + (size_t)l * 2048 * 1024; colt &= 1023;
        const int col0 = colt + wc * 32 + 4 * fq;
#pragma unroll
        for (int ai = 0; ai < 2; ++ai)
#pragma unroll
            for (int m = 0; m < 4; ++m) { float* rowp = base + (size_t)(row0 + ai * HALF + m * 16) * 1024 + col0;
#pragma unroll
                for (int bj = 0; bj < 2; ++bj)
#pragma unroll
                    for (int n = 0; n < 2; ++n) *(f32x4*)(rowp + bj * HALF + n * 16) = acc[ai][bj][m][n]; }
    }
};
struct MemKVOrder {
    int G, c;
    __host__ __device__ bool next(int i, Unit& u) const { const int L = i * G + c; if (L >= 256) return false; const int l = L >> 6, r = L & 63; u.pm = l * 8 + (r >> 3); u.pn = l * 8 + (r & 7); return true; }
    __device__ __forceinline__ void a_ready(const Unit&) const {}
    __device__ __forceinline__ void done(const Unit&) const {}
};
struct EpiU {
    static constexpr bool AFTER_DRAIN = false;
    int mode; bool perm; bf16_t* O; const bf16_t* T; float* F; float* F2; int ldc; int first;
    __device__ __forceinline__ void operator()(const f32x4 (&acc)[2][2][4][2], const Unit& u, int wr, int wc, int fr, int fq) const {
        if (mode == 0) { EpiAct<0> e{O, ldc}; e(acc, u, wr, wc, fr, fq); }
        else if (mode == 1) { EpiAct<1> e{O, ldc}; e(acc, u, wr, wc, fr, fq); }
        else if (mode == 2) { EpiAct<2> e{O, ldc}; e(acc, u, wr, wc, fr, fq); }
        else if (mode == 3) { EpiGate e{T, O, ldc, first}; e(acc, u, wr, wc, fr, fq); }
        else if (mode == 4) { EpiResid e{F, ldc}; e(acc, u, wr, wc, fr, fq); }
        else { EpiMemKV e{F, F2}; e(acc, u, wr, wc, fr, fq); }
    }
};
struct OrderU {
    StaticOrder so; int memkv; int half;
    __device__ bool next(int i, Unit& u) const {
        if (half) { if (!so.next(i, u)) return false; const int tpb = half == 2 ? 23 : 9; const int bq = u.pm / tpb; u.pm = bq * 32 + (u.pm - bq * tpb) + (half == 2 ? 9 : 0); return true; }
        if (memkv) { const int L = i * so.G + so.c; if (L >= 256) return false; const int l = L >> 6, r = L & 63; u.pm = l * 8 + (r >> 3); u.pn = l * 8 + (r & 7); return true; }
        return so.next(i, u);
    }
    __device__ __forceinline__ void a_ready(const Unit&) const {}
    __device__ __forceinline__ void done(const Unit&) const {}
};
template <class Epi, class Sched, bool ALIGN_EPI = false, bool SP2 = false>
__device__ __forceinline__ void gemm_phase(PG8_LAS unsigned char* lds, const Gemm g, const Sched& S, const Epi& E) {
    int tid_ = threadIdx.x; asm volatile("" : "+v"(tid_)); const int tid = tid_, wid = __builtin_amdgcn_readfirstlane(tid >> 6), lane = tid & 63, wr = wid >> 2, wc = wid & 3, fr = lane & 15, fq = lane >> 4;
    const int K = g.K, nt = K / BK;
    unsigned voffA[2], voffB[2];
#pragma unroll
    for (int i = 0; i < 2; ++i) { int R, C; stage_rc(tid * 16 + i * 8192, R, C); const int Rb = E.perm ? ((R & ~31) + perm32(R & 31)) : R;
        voffA[i] = (unsigned)(R * g.lda + C) * 2u; voffB[i] = (unsigned)(Rb * K + C) * 2u; }
    const size_t kstep = (size_t)(BK * 2);
    const size_t hstep = (size_t)HALF * K * 2;
    const size_t tstep = 2 * hstep;
    const size_t hstepA = (size_t)HALF * g.lda * 2, tstepA = 2 * hstepA;
    const unsigned ldsw = (unsigned)wid * 1024u;
    const int aoff = lds_byte(wr * 64 + fr, fq * 8), boff = lds_byte(wc * 32 + fr, fq * 8);
#define PG8_SA(b, h) (((b) * 2 + (h)) * HTB)
#define PG8_SB(b, h) ((4 + (b) * 2 + (h)) * HTB)
#define PG8_STAGE(bufoff, gbase, voff) do { _Pragma("unroll") for (int _i = 0; _i < 2; ++_i) \
        __builtin_amdgcn_global_load_lds((const unsigned*)((const char*)(gbase) + (voff)[_i]), (PG8_LAS unsigned*)(lds + (bufoff) + ldsw + _i * 8192), 16, 0, 0); } while (0)
#define PG8_LDA(dst, b, h) do { _Pragma("unroll") for (int m = 0; m < 4; ++m) _Pragma("unroll") for (int k = 0; k < 2; ++k) dst[m][k] = *(const PG8_LAS bf16x8*)(lds + PG8_SA(b, h) + aoff + m * 2048 + k * 1024); } while (0)
#define PG8_LDB(dst, b, h) do { _Pragma("unroll") for (int n = 0; n < 2; ++n) _Pragma("unroll") for (int k = 0; k < 2; ++k) dst[n][k] = *(const PG8_LAS bf16x8*)(lds + PG8_SB(b, h) + boff + n * 2048 + k * 1024); } while (0)
#define PG8_MMA(ai, bj, At, Bt) do { __builtin_amdgcn_s_setprio(1); _Pragma("unroll") for (int m = 0; m < 4; ++m) _Pragma("unroll") for (int n = 0; n < 2; ++n) _Pragma("unroll") for (int k = 0; k < 2; ++k) \
        acc[ai][bj][m][n] = __builtin_amdgcn_mfma_f32_16x16x32_bf16(Bt[n][k], At[m][k], acc[ai][bj][m][n], 0, 0, 0); __builtin_amdgcn_s_setprio(0); } while (0)
#define PG8_WAIT_V(n) asm volatile("s_waitcnt vmcnt(" #n ")" ::: "memory")
#define PG8_WAIT_L(n) asm volatile("s_waitcnt lgkmcnt(" #n ")" ::: "memory")
#define PG8_BAR __builtin_amdgcn_s_barrier()
#define PG8_SCHED __builtin_amdgcn_sched_barrier(0)
    Unit cur, nxt; int ui = 0;
    if (!S.next(0, cur)) return;
    f32x4 acc[2][2][4][2];
#pragma unroll
    for (int a = 0; a < 2; ++a)
#pragma unroll
        for (int b = 0; b < 2; ++b)
#pragma unroll
            for (int m = 0; m < 4; ++m)
#pragma unroll
                for (int n = 0; n < 2; ++n) acc[a][b][m][n] = (f32x4){0.f, 0.f, 0.f, 0.f};
    bf16x8 At[4][2], B0[2][2], B1[2][2];
    const char* cA = (const char*)g.A + (size_t)cur.pm * tstepA; const char* cB = (const char*)g.Bt + (size_t)cur.pn * tstep;
    S.a_ready(cur);
    if constexpr (SP2) {
        PG8_STAGE(PG8_SB(0, 0), cB, voffB); PG8_STAGE(PG8_SB(0, 1), cB + hstep, voffB); PG8_STAGE(PG8_SA(0, 0), cA, voffA); PG8_STAGE(PG8_SA(0, 1), cA + hstepA, voffA);
        if (wr == 1) PG8_BAR;
        PG8_WAIT_V(2); PG8_BAR;
        PG8_STAGE(PG8_SB(1, 0), cB + kstep, voffB); PG8_STAGE(PG8_SA(1, 0), cA + kstep, voffA); PG8_STAGE(PG8_SB(1, 1), cB + hstep + kstep, voffB);
        PG8_WAIT_V(6); PG8_BAR;
    } else {
        PG8_STAGE(PG8_SB(0, 0), cB, voffB); PG8_STAGE(PG8_SA(0, 0), cA, voffA); PG8_STAGE(PG8_SB(0, 1), cB + hstep, voffB); PG8_STAGE(PG8_SA(0, 1), cA + hstepA, voffA);
        if (wr == 1) PG8_BAR;
        PG8_WAIT_V(4); PG8_BAR;
        PG8_STAGE(PG8_SB(1, 0), cB + kstep, voffB); PG8_STAGE(PG8_SA(1, 0), cA + kstep, voffA); PG8_STAGE(PG8_SB(1, 1), cB + hstep + kstep, voffB);
        PG8_WAIT_V(6); PG8_BAR;
    }
    for (;;) {
        const bool has_next = S.next(ui + 1, nxt);
        const char* nA = has_next ? (const char*)g.A + (size_t)nxt.pm * tstepA : cA; const char* nB = has_next ? (const char*)g.Bt + (size_t)nxt.pn * tstep : cB;
        for (int t = 0; t < nt; t += 2) {
            const bool last = (t == nt - 2);
            const char* a1 = cA + (size_t)(t + 1) * kstep;
            const char* a2 = last ? nA : cA + (size_t)(t + 2) * kstep; const char* b2 = last ? nB : cB + (size_t)(t + 2) * kstep;
            const char* a3 = a2 + kstep; const char* b3 = b2 + kstep;
            if (last && has_next) S.a_ready(nxt);
            if constexpr (SP2) {
            PG8_LDB(B0, 0, 0); PG8_LDB(B1, 0, 1); PG8_SCHED; PG8_LDA(At, 0, 0); PG8_STAGE(PG8_SA(1, 1), a1 + hstepA, voffA);
            PG8_WAIT_V(8); PG8_WAIT_L(0); PG8_BAR; PG8_MMA(0, 0, At, B0); PG8_MMA(0, 1, At, B1); PG8_BAR; PG8_SCHED;
            PG8_LDA(At, 0, 1); PG8_STAGE(PG8_SB(0, 0), b2, voffB); PG8_STAGE(PG8_SB(0, 1), b2 + hstep, voffB); PG8_STAGE(PG8_SA(0, 0), a2, voffA);
            PG8_WAIT_V(8); PG8_WAIT_L(0); PG8_BAR; PG8_MMA(1, 0, At, B0); PG8_MMA(1, 1, At, B1); PG8_BAR; PG8_SCHED;
            PG8_LDB(B0, 1, 0); PG8_LDB(B1, 1, 1); PG8_SCHED; PG8_LDA(At, 1, 0); PG8_STAGE(PG8_SA(0, 1), a2 + hstepA, voffA);
            PG8_WAIT_V(8); PG8_WAIT_L(0); PG8_BAR; PG8_MMA(0, 0, At, B0); PG8_MMA(0, 1, At, B1); PG8_BAR; PG8_SCHED;
            PG8_LDA(At, 1, 1); PG8_STAGE(PG8_SB(1, 0), b3, voffB); PG8_STAGE(PG8_SB(1, 1), b3 + hstep, voffB); PG8_STAGE(PG8_SA(1, 0), a3, voffA);
            PG8_WAIT_V(8); PG8_WAIT_L(0); PG8_BAR; PG8_MMA(1, 0, At, B0); PG8_MMA(1, 1, At, B1); PG8_BAR; PG8_SCHED;
            } else {
            PG8_LDB(B0, 0, 0); PG8_SCHED; PG8_LDA(At, 0, 0); PG8_STAGE(PG8_SA(1, 1), a1 + hstepA, voffA);
            PG8_WAIT_L(8); PG8_BAR; PG8_WAIT_L(0); PG8_MMA(0, 0, At, B0); PG8_BAR; PG8_SCHED;
            PG8_LDB(B1, 0, 1); PG8_STAGE(PG8_SB(0, 0), b2, voffB);
            PG8_BAR; PG8_WAIT_L(0); PG8_MMA(0, 1, At, B1); PG8_BAR;
            PG8_LDA(At, 0, 1); PG8_STAGE(PG8_SA(0, 0), a2, voffA);
            PG8_BAR; PG8_WAIT_L(0); PG8_MMA(1, 0, At, B0); PG8_BAR; PG8_SCHED;
            PG8_STAGE(PG8_SB(0, 1), b2 + hstep, voffB);
            PG8_WAIT_V(6); PG8_BAR; PG8_MMA(1, 1, At, B1); PG8_BAR;
            PG8_LDB(B0, 1, 0); PG8_SCHED; PG8_LDA(At, 1, 0); PG8_STAGE(PG8_SA(0, 1), a2 + hstepA, voffA);
            PG8_WAIT_L(8); PG8_BAR; PG8_WAIT_L(0); PG8_MMA(0, 0, At, B0); PG8_BAR; PG8_SCHED;
            PG8_LDB(B1, 1, 1); PG8_STAGE(PG8_SB(1, 0), b3, voffB);
            PG8_BAR; PG8_WAIT_L(0); PG8_MMA(0, 1, At, B1); PG8_BAR;
            PG8_LDA(At, 1, 1); PG8_STAGE(PG8_SA(1, 0), a3, voffA);
            PG8_BAR; PG8_WAIT_L(0); PG8_MMA(1, 0, At, B0); PG8_BAR; PG8_SCHED;
            PG8_STAGE(PG8_SB(1, 1), b3 + hstep, voffB);
            PG8_WAIT_V(6); PG8_BAR; PG8_MMA(1, 1, At, B1); PG8_BAR;
            }
        }
        if constexpr (ALIGN_EPI) { if (wr == 0) PG8_BAR; }
        if constexpr (!Epi::AFTER_DRAIN) { E(acc, cur, wr, wc, fr, fq); S.done(cur); }
        if (!has_next) break;
#pragma unroll
        for (int a = 0; a < 2; ++a)
#pragma unroll
            for (int b = 0; b < 2; ++b)
#pragma unroll
                for (int m = 0; m < 4; ++m)
#pragma unroll
                    for (int n = 0; n < 2; ++n) acc[a][b][m][n] = (f32x4){0.f, 0.f, 0.f, 0.f};
        cur = nxt; cA = nA; cB = nB; ++ui;
        if constexpr (ALIGN_EPI) { if (wr == 1) PG8_BAR; }
    }
    PG8_WAIT_V(0);
    if constexpr (!ALIGN_EPI) { if (wr == 0) PG8_BAR; }
    PG8_BAR;
    if constexpr (Epi::AFTER_DRAIN) { E.fused(acc, cur, wr, wc, fr, fq, lds, wid, lane); S.done(cur); }
#undef PG8_SA
#undef PG8_SB
#undef PG8_STAGE
#undef PG8_LDA
#undef PG8_LDB
#undef PG8_MMA
#undef PG8_WAIT_V
#undef PG8_WAIT_L
#undef PG8_BAR
#undef PG8_SCHED
}
}
#define LAS __attribute__((address_space(3)))
typedef unsigned short bf16;
typedef unsigned v4u __attribute__((ext_vector_type(4)));
typedef unsigned v2u __attribute__((ext_vector_type(2)));
typedef float f32x4 __attribute__((ext_vector_type(4)));
typedef float f32x2 __attribute__((ext_vector_type(2)));
typedef short bf16x8 __attribute__((ext_vector_type(8)));
constexpr int NT = 512, NWAVES = 8;
constexpr int DM = 1024, NB = 8, SEQ = 8192, DEPTH = 4, DECS = 32;
constexpr int MP = NB * SEQ, MS = NB * DECS, M = MP + MS;
constexpr int RC = 3328, INC = 9472, COL_GMLP = 3328, COL_Q = 5376, COL_GATE = 6400, DFF = 4096;
constexpr int NMEM = 256;
constexpr size_t O_Y = 0, O_MK = (size_t)M * DM, O_MV = O_MK + (size_t)DEPTH * NB * NMEM * DM, O_WKVP = O_MV + (size_t)DEPTH * NB * NMEM * DM,
    O_SHP = O_WKVP + (size_t)DEPTH * NB * 16 * 64 * 64, O_WKVS = O_SHP + (size_t)DEPTH * NB * RC, O_SHS = O_WKVS + (size_t)DEPTH * NB * 16 * 64 * 64,
    O_SGUV = O_SHS + (size_t)DEPTH * NB * RC, O_END = O_SGUV + (size_t)DEPTH * NB * DECS * DM;
constexpr size_t A1 = (size_t)M * DM * 2;
constexpr size_t WS_WIN = 1u << 20;
constexpr size_t WS_WB = WS_WIN + (size_t)INC * DM * 2;
constexpr size_t WS_WOUT = WS_WB + 3ull * DM * DM * 2;
constexpr size_t WS_WUP = WS_WOUT + (size_t)DM * DM * 2;
constexpr size_t WS_WDN = WS_WUP + (size_t)DFF * DM * 2;
constexpr size_t WS_W2T = WS_WDN + (size_t)DFF * DM * 2;
constexpr size_t WS_A2T = WS_W2T + 1024 * 64 * 2;
constexpr size_t WS_G2T = WS_A2T + 1024 * 64 * 2;
constexpr size_t WS_WS = WS_G2T + 1024 * 128 * 2;
constexpr size_t WS_KB = WS_WS + 8 * 128 * 128 * 2;
constexpr size_t WS_VT = WS_KB + 16ull * 256 * 1024 * 2;
constexpr size_t WS_H = WS_VT + 16ull * 256 * 1024 * 2;
constexpr size_t WS_Y = WS_H + A1, WS_T = WS_Y + A1, WS_MG = WS_T + A1, WS_BIG = WS_MG + A1;
constexpr size_t WS_END = WS_BIG + (size_t)M * RC * 2;
constexpr size_t WS_UVB = WS_T;
constexpr size_t WS_T2 = WS_BIG, WS_MG2 = WS_BIG + A1;
constexpr size_t WS_UP = WS_Y;
static_assert(WS_UP + (size_t)M * DFF * 2 <= WS_END, "up overlay");
constexpr size_t WS_AMEM = WS_BIG;
constexpr size_t WS_WMKV = WS_BIG + 4ull * 2048 * 1024 * 2;
static_assert(WS_END <= (1024ull << 20), "workspace");
constexpr int LDS_BYTES = 147456;

struct Args { const float* in[32]; float* out; unsigned char* ws; };

__device__ __forceinline__ unsigned f2bf(float f) { unsigned u = __builtin_bit_cast(unsigned, f); return (u + 0x7fffu + ((u >> 16) & 1u)) >> 16; }
__device__ __forceinline__ unsigned pk2(float lo, float hi) { return pg8::cvt_pk_bf16(lo, hi); }
typedef __bf16 bf16x2_t __attribute__((ext_vector_type(2)));
__device__ __forceinline__ unsigned pk2c(float lo, float hi) { const f32x2 v = {lo, hi}; const bf16x2_t b = __builtin_convertvector(v, bf16x2_t); return __builtin_bit_cast(unsigned, b); }
__device__ __forceinline__ float bflo(unsigned w) { return __uint_as_float(w << 16); }
__device__ __forceinline__ float bfhi(unsigned w) { return __uint_as_float(w & 0xffff0000u); }
__device__ __forceinline__ void unpack8(const v4u w, float* o) { o[0] = bflo(w.x); o[1] = bfhi(w.x); o[2] = bflo(w.y); o[3] = bfhi(w.y); o[4] = bflo(w.z); o[5] = bfhi(w.z); o[6] = bflo(w.w); o[7] = bfhi(w.w); }
__device__ __forceinline__ v4u pack8(const float* o) { v4u w; w.x = pk2(o[0], o[1]); w.y = pk2(o[2], o[3]); w.z = pk2(o[4], o[5]); w.w = pk2(o[6], o[7]); return w; }
__device__ __forceinline__ float wave_sum(float v) {
#pragma unroll
    for (int o = 1; o < 64; o <<= 1) v += __shfl_xor(v, o);
    return v;
}
template <int CTRL> __device__ __forceinline__ float dppf(float x) { return __builtin_bit_cast(float, __builtin_amdgcn_mov_dpp(__builtin_bit_cast(int, x), CTRL, 0xf, 0xf, true)); }
__device__ __forceinline__ float row16_sum(float v) { v += dppf<0xB1>(v); v += dppf<0x4E>(v); v += dppf<0x141>(v); v += dppf<0x128>(v); return v; }
#define LDS_WAIT() asm volatile("s_waitcnt lgkmcnt(0)" ::: "memory")
__device__ __forceinline__ void sub_barrier(unsigned* cnt, unsigned target) {
    asm volatile("s_waitcnt vmcnt(0)" ::: "memory");
    __syncthreads();
    if (threadIdx.x == 0) {
        __builtin_amdgcn_fence(__ATOMIC_RELEASE, "agent");
        asm volatile("s_waitcnt vmcnt(0)" ::: "memory");
        __hip_atomic_fetch_add(cnt, 1u, __ATOMIC_RELAXED, __HIP_MEMORY_SCOPE_AGENT);
        while (__hip_atomic_load(cnt, __ATOMIC_RELAXED, __HIP_MEMORY_SCOPE_AGENT) < target) __builtin_amdgcn_s_sleep(2);
        __builtin_amdgcn_fence(__ATOMIC_ACQUIRE, "agent");
        asm volatile("s_waitcnt vmcnt(0)" ::: "memory");
    }
    __syncthreads();
}

__device__ __forceinline__ void transpose_item(const float* W, int ldw, int N, bf16* WT, int ldt, LAS float* scr, int item, int lane, bool vperm) {
    const int nblk = N / 32, kb = item / nblk, nb = item % nblk, k0 = 64 * kb, n0 = 32 * nb;
#pragma unroll 8
    for (int i = 0; i < 32; ++i) { const int kk = 2 * i + (lane >> 5); scr[kk * 33 + (lane & 31)] = W[(size_t)(k0 + kk) * ldw + n0 + (lane & 31)]; }
    LDS_WAIT();
    const int c = lane & 7;
    const int rlo = vperm ? ((c >> 2) * 32 + 4 * (c & 3)) : 8 * c, rhi = vperm ? rlo + 16 : rlo + 4;
#pragma unroll
    for (int j = 0; j < 4; ++j) { const int n = (lane >> 3) + 8 * j; const LAS float* s = scr + rlo * 33 + n; const LAS float* s2 = scr + rhi * 33 + n;
        v4u o; o.x = pk2(s[0 * 33], s[1 * 33]); o.y = pk2(s[2 * 33], s[3 * 33]); o.z = pk2(s2[0 * 33], s2[1 * 33]); o.w = pk2(s2[2 * 33], s2[3 * 33]);
        *(v4u*)(WT + (size_t)(n0 + n) * ldt + k0 + 8 * c) = o; }
    LDS_WAIT();
}
__device__ __forceinline__ void rms_row_bf16(const float* xrow, const float* g, bf16* orow, int lane) {
    const f32x4* xr = (const f32x4*)xrow + lane; const f32x4* gr = (const f32x4*)g + lane;
    f32x4 v[4]; float s = 0.f;
#pragma unroll
    for (int j = 0; j < 4; ++j) { v[j] = xr[64 * j]; s += (v[j].x * v[j].x + v[j].y * v[j].y) + (v[j].z * v[j].z + v[j].w * v[j].w); }
    const float r = 1.0f / sqrtf(wave_sum(s) * (1.f / DM) + 1e-6f);
    v2u* o8 = (v2u*)orow + lane;
#pragma unroll
    for (int j = 0; j < 4; ++j) { const f32x4 gg = gr[64 * j]; v2u w; w.x = pk2(v[j].x * r * gg.x, v[j].y * r * gg.y); w.y = pk2(v[j].z * r * gg.z, v[j].w * r * gg.w); o8[64 * j] = w; }
}

struct Ctx {
    const float* const* in; float* out; unsigned char* ws; LAS unsigned char* lds;
    int tid, lane, wave, gw, ngw;
};

__device__ __forceinline__ void prep_phase(const Ctx& C, int kind, int l2) {
    LAS float* scr = (LAS float*)(C.lds + C.wave * 16384);
    constexpr int I_IN = 16 * (INC / 32), I_SQ = 16 * 32, I_UP = 16 * (DFF / 32), I_DN = 64 * 32, I_L64 = 32, I_L128 = 64, I_VT = 16 * 4 * 32;
    constexpr int NIT = I_IN + 4 * I_SQ + I_UP + I_DN + 2 * I_L64 + I_L128 + I_VT;
    constexpr int ITM = (1024 / 64) * (2048 / 32);
    const int l = kind >= 0 ? kind : 0;
    const int nit = kind >= 0 ? NIT : kind == -1 ? 4 * ITM : 0;
    for (int it = C.gw; it < nit; it += C.ngw) {
        int r = it; const float* src; int ldw, N, ldt; size_t dst; bool vperm = false;
        if (kind < 0) { const int ll = it / ITM; r = it % ITM; src = C.in[12] + (size_t)ll * 1024 * 2048; ldw = 2048; N = 2048; dst = WS_WMKV + (size_t)ll * 2048 * 1024 * 2; ldt = 1024; }
        else if (r < I_IN) { src = C.in[11] + (size_t)l * DM * INC; ldw = INC; N = INC; dst = WS_WIN; ldt = DM; }
        else if ((r -= I_IN) < 3 * I_SQ) { const int b = r / I_SQ; r = r % I_SQ; src = C.in[28] + ((size_t)l * 3 + b) * DM * DM; ldw = DM; N = DM; dst = WS_WB + (size_t)b * DM * DM * 2; ldt = DM; }
        else if ((r -= 3 * I_SQ) < I_SQ) { src = C.in[29] + (size_t)l * DM * DM; ldw = DM; N = DM; dst = WS_WOUT; ldt = DM; }
        else if ((r -= I_SQ) < I_UP) { src = C.in[30] + (size_t)l * DM * DFF; ldw = DFF; N = DFF; dst = WS_WUP; ldt = DM; }
        else if ((r -= I_UP) < I_DN) { src = C.in[31] + (size_t)l * DFF * DM; ldw = DM; N = DM; dst = WS_WDN; ldt = DFF; }
        else if ((r -= I_DN) < I_L64) { src = C.in[15] + (size_t)l * 64 * DM; ldw = DM; N = DM; dst = WS_W2T; ldt = 64; }
        else if ((r -= I_L64) < I_L64) { src = C.in[17] + (size_t)l * 64 * DM; ldw = DM; N = DM; dst = WS_A2T; ldt = 64; }
        else if ((r -= I_L64) < I_L128) { src = C.in[18] + (size_t)l * 128 * DM; ldw = DM; N = DM; dst = WS_G2T; ldt = 128; }
        else { r -= I_L128; const int bbh = r >> 5, bb = bbh >> 2, h = bbh & 3; r &= 31;
            src = (bb < 8 ? C.out + O_MV + ((size_t)l * 8 + bb) * 256 * 1024 : C.in[3] + ((size_t)l * 8 + (bb - 8)) * 256 * 1024) + h * 256;
            ldw = 1024; N = 256; dst = WS_VT + (size_t)bbh * 65536 * 2; ldt = 256; vperm = true; }
        transpose_item(src, ldw, N, (bf16*)(C.ws + dst), ldt, scr, r, C.lane, vperm);
    }
    if (kind == -1) {
        float* X = C.out;
        const f32x4* s = (const f32x4*)C.in[0]; f32x4* d = (f32x4*)X; const size_t n = (size_t)MP * DM / 4;
        for (size_t i = (size_t)blockIdx.x * NT + C.tid; i < n; i += (size_t)gridDim.x * NT) d[i] = s[i];
        const f32x4* s2 = (const f32x4*)C.in[1]; f32x4* d2 = (f32x4*)(X + (size_t)MP * DM); const size_t n2 = (size_t)MS * DM / 4;
        for (size_t i = (size_t)blockIdx.x * NT + C.tid; i < n2; i += (size_t)gridDim.x * NT) d2[i] = s2[i];
    }
    if (kind >= 0) {
        { v4u* d = (v4u*)(C.ws + WS_KB); const size_t n = 16ull * 256 * 1024 / 8;
          for (size_t i = (size_t)blockIdx.x * NT + C.tid; i < n; i += (size_t)gridDim.x * NT) { const size_t e = i * 8; const int bb = (int)(e >> 18); const size_t o = e & 262143;
              const float* s = (bb < 8 ? C.out + O_MK + ((size_t)l * 8 + bb) * 262144 : C.in[2] + ((size_t)l * 8 + (bb - 8)) * 262144) + o;
              const f32x4 a = *(const f32x4*)s, b = *(const f32x4*)(s + 4); v4u w; w.x = pk2(a.x, a.y); w.y = pk2(a.z, a.w); w.z = pk2(b.x, b.y); w.w = pk2(b.z, b.w); d[i] = w; } }
        { bf16* d = (bf16*)(C.ws + WS_WS); const float* s = C.in[26] + (size_t)l * 8 * 128 * 128;
          for (int i = blockIdx.x * NT + C.tid; i < 8 * 128 * 128; i += gridDim.x * NT) { const int ii = (i >> 7) & 127, jj = i & 127; d[i] = (bf16)f2bf(jj <= ii ? s[i] : 0.f); } }
    }
    { const float* sb; const float* gb; size_t db; int nrows, smask, gshift;
      if (kind == -1) { sb = C.in[6]; gb = C.in[8]; db = WS_AMEM; nrows = 4 * 2048; smask = 2047; gshift = 11; }
      else { sb = C.out; gb = (kind >= 0 ? C.in[7] : C.in[9]) + (kind >= 0 ? l : l2) * DM; db = WS_H; nrows = M; smask = 0x7fffffff; gshift = 30; }
      for (int it = C.gw; it < nrows; it += 2 * C.ngw) { const int it2 = it + C.ngw;
          const f32x4* xa = (const f32x4*)(sb + (size_t)(it & smask) * DM) + C.lane; const bool has2 = it2 < nrows; const f32x4* xb = (const f32x4*)(sb + (size_t)((has2 ? it2 : it) & smask) * DM) + C.lane;
          f32x4 va[4], vb[4]; float sa = 0.f, sb2 = 0.f;
#pragma unroll
          for (int j = 0; j < 4; ++j) { va[j] = xa[64 * j]; vb[j] = xb[64 * j]; }
#pragma unroll
          for (int j = 0; j < 4; ++j) { sa += (va[j].x * va[j].x + va[j].y * va[j].y) + (va[j].z * va[j].z + va[j].w * va[j].w); sb2 += (vb[j].x * vb[j].x + vb[j].y * vb[j].y) + (vb[j].z * vb[j].z + vb[j].w * vb[j].w); }
          const float ra = 1.0f / sqrtf(wave_sum(sa) * (1.f / DM) + 1e-6f), rb = 1.0f / sqrtf(wave_sum(sb2) * (1.f / DM) + 1e-6f);
          const f32x4* ga = (const f32x4*)(gb + (size_t)(it >> gshift) * DM) + C.lane; const f32x4* gb2 = (const f32x4*)(gb + (size_t)((has2 ? it2 : it) >> gshift) * DM) + C.lane;
          v2u* oa = (v2u*)((bf16*)(C.ws + db) + (size_t)it * DM) + C.lane; v2u* ob = (v2u*)((bf16*)(C.ws + db) + (size_t)(has2 ? it2 : it) * DM) + C.lane;
#pragma unroll
          for (int j = 0; j < 4; ++j) { const f32x4 g1 = ga[64 * j], g2 = gb2[64 * j]; v2u w1, w2;
              w1.x = pk2(va[j].x * ra * g1.x, va[j].y * ra * g1.y); w1.y = pk2(va[j].z * ra * g1.z, va[j].w * ra * g1.w); oa[64 * j] = w1;
              w2.x = pk2(vb[j].x * rb * g2.x, vb[j].y * rb * g2.y); w2.y = pk2(vb[j].z * rb * g2.z, vb[j].w * rb * g2.w); if (has2) ob[64 * j] = w2; } } }
}

constexpr int RW_MAIN = 0, RW_MSTR = 20608, RW_POST = 41216, RW_YC = 66176, RW_XL = 74368, RW_ZR = 83072, RW_LW = 95360, RW_MU = 131200;
struct RawRegs { v4u cur[4]; v4u prv[4]; };
__device__ __forceinline__ float row8_sum(float v) { v += dppf<0xB1>(v); v += dppf<0x4E>(v); v += dppf<0x141>(v); return v; }
__device__ __forceinline__ void rw_issue(RawRegs& rr, const bf16* PRu, int T, int cn, int pw, const int (&ioff)[4], const int (&itl)[4]) {
    const bf16* pc = PRu + (size_t)cn * (16 * RC);
#pragma unroll
    for (int j = 0; j < 4; ++j) { const int t = cn * 16 + 4 * pw + itl[j];
        rr.cur[j] = (v4u){0u, 0u, 0u, 0u}; rr.prv[j] = (v4u){0u, 0u, 0u, 0u};
        if (ioff[j] >= 0 && t < T) { rr.cur[j] = *(const v4u*)(pc + ioff[j]); if (t > 0) rr.prv[j] = *(const v4u*)(pc + ioff[j] - RC); } }
}
template <int KIND> __device__ __forceinline__ void rw_a1_item(const v4u cw, const v4u pw_, int t, int t4, int q, int tok, const LAS float* MU, LAS float* Mb, LAS float* Pf, LAS bf16* XLw) {
    float cur[8], prv[8]; unpack8(cw, cur); unpack8(pw_, prv);
    if (t == 0) { const f32x4 x0 = *(const LAS f32x4*)(MU + 448 + q * 8), x1 = *(const LAS f32x4*)(MU + 452 + q * 8);
        prv[0] = x0.x; prv[1] = x0.y; prv[2] = x0.z; prv[3] = x0.w; prv[4] = x1.x; prv[5] = x1.y; prv[6] = x1.z; prv[7] = x1.w; }
    const f32x4 m0 = *(const LAS f32x4*)(MU + q * 8), m1 = *(const LAS f32x4*)(MU + q * 8 + 4);
    const float mm[8] = {m0.x, m0.y, m0.z, m0.w, m1.x, m1.y, m1.z, m1.w}; float mx[8];
#pragma unroll
    for (int e = 0; e < 8; ++e) mx[e] = cur[e] + (prv[e] - cur[e]) * mm[e];
    if (KIND == 0) { LAS float* dst = (q < 8 ? Mb : q < 16 ? Mb + 1024 : Pf + 1024) + tok * 64 + (q & 7) * 8;
        *(LAS f32x4*)dst = (f32x4){mx[0], mx[1], mx[2], mx[3]}; *(LAS f32x4*)(dst + 4) = (f32x4){mx[4], mx[5], mx[6], mx[7]}; }
    else { float o[8];
#pragma unroll
        for (int e = 0; e < 8; ++e) { if (KIND == 1) o[e] = mx[e]; else if (KIND == 2) { const float ex = __expf(2.0f * mx[e]); o[e] = 1.0f - 2.0f * __builtin_amdgcn_rcpf(ex + 1.0f); } else o[e] = pg8::fast_sigmoid(mx[e]); }
        *(LAS v4u*)(XLw + t4 * 264 + (q - 24) * 8) = pack8(o); }
}
__device__ __forceinline__ void rwkv_unit(const Ctx& C, int l, int sample, int b, int h) {
    LAS unsigned char* L = C.lds;
    const int T = sample ? DECS : SEQ, NC = T / 16; const size_t rowbase = sample ? (size_t)MP + (size_t)b * DECS : (size_t)b * SEQ;
    const bf16* PR = (const bf16*)(C.ws + WS_BIG); bf16* Yg = (bf16*)(C.ws + WS_Y);
    const int lane = C.lane, w = C.wave;
    __syncthreads();
    if (w < 4) {
        const int rowl = lane & 15, fq = lane >> 4, row = 16 * w + rowl;
        const unsigned m0 = fq == 0 ? 0xffffffffu : 0u;
        f32x4 S0 = (f32x4){0.f, 0.f, 0.f, 0.f}, S1 = S0, S2 = S0, S3 = S0;
        if (sample) { const float* sp = C.in[4] + ((((size_t)l * 8 + b) * 16 + h) * 64 + row) * 64 + 4 * fq;
            S0 = *(const f32x4*)sp; S1 = *(const f32x4*)(sp + 16); S2 = *(const f32x4*)(sp + 32); S3 = *(const f32x4*)(sp + 48); }
        const int asel = ((rowl & 3) == 0 ? 0 : 1024) + 4 * fq;
        __syncthreads();
        __syncthreads();
        for (int c = 0; c < NC; ++c) {
            const LAS float* Mb = (const LAS float*)(L + RW_MAIN + (c & 1) * RW_MSTR);
            const LAS float* Wp = Mb + 2048 + 4 * fq;
            const LAS unsigned* BKp = (const LAS unsigned*)(Mb + 4096) + rowl;
            const LAS bf16* Ap = (const LAS bf16*)(Mb + 3072) + asel;
            const LAS float* Vb = (const LAS float*)(L + RW_POST + (c % 3) * 8320 + 4096) + row;
            LAS float* Yb = (LAS float*)(L + RW_YC + (c & 1) * 4096) + row;
#define RW_LD(t_, W0, W1, W2, W3, K0, K1, K2, K3, A00, A01, A10, A11, VV, SC) do { const int o_ = (t_) * 64; \
                W0 = *(const LAS f32x4*)(Wp + o_); W1 = *(const LAS f32x4*)(Wp + o_ + 16); W2 = *(const LAS f32x4*)(Wp + o_ + 32); W3 = *(const LAS f32x4*)(Wp + o_ + 48); \
                K0 = BKp[o_]; K1 = BKp[o_ + 16]; K2 = BKp[o_ + 32]; K3 = BKp[o_ + 48]; \
                A00 = *(const LAS v2u*)(Ap + o_); A01 = *(const LAS v2u*)(Ap + o_ + 16); A10 = *(const LAS v2u*)(Ap + o_ + 32); A11 = *(const LAS v2u*)(Ap + o_ + 48); \
                VV = Vb[o_]; SC = *(const LAS f32x2*)(Mb + 5120 + (t_) * 2); } while (0)
            f32x4 w_0, w_1, w_2, w_3; unsigned k_0, k_1, k_2, k_3; v2u a00, a01, a10, a11; float vv; f32x2 sc;
            RW_LD(0, w_0, w_1, w_2, w_3, k_0, k_1, k_2, k_3, a00, a01, a10, a11, vv, sc);
#pragma unroll 2
            for (int t = 0; t < 16; ++t) {
                const int tn = t < 15 ? t + 1 : 15;
                f32x4 nw_0, nw_1, nw_2, nw_3; unsigned nk_0, nk_1, nk_2, nk_3; v2u na00, na01, na10, na11; float nvv; f32x2 nsc;
                RW_LD(tn, nw_0, nw_1, nw_2, nw_3, nk_0, nk_1, nk_2, nk_3, na00, na01, na10, na11, nvv, nsc);
                v4u sb0, sb1; sb0.x = pk2c(S0.x, S0.y); sb0.y = pk2c(S0.z, S0.w); sb0.z = pk2c(S1.x, S1.y); sb0.w = pk2c(S1.z, S1.w);
                sb1.x = pk2c(S2.x, S2.y); sb1.y = pk2c(S2.z, S2.w); sb1.z = pk2c(S3.x, S3.y); sb1.w = pk2c(S3.z, S3.w);
                const v4u af0 = (v4u){a00.x, a00.y, a01.x, a01.y}, af1 = (v4u){a10.x, a10.y, a11.x, a11.y};
                f32x4 d = __builtin_amdgcn_mfma_f32_16x16x32_bf16(__builtin_bit_cast(bf16x8, af0), __builtin_bit_cast(bf16x8, sb0), (f32x4){0.f, 0.f, 0.f, 0.f}, 0, 0, 0);
                d = __builtin_amdgcn_mfma_f32_16x16x32_bf16(__builtin_bit_cast(bf16x8, af1), __builtin_bit_cast(bf16x8, sb1), d, 0, 0, 0);
                const float sa = d.x; const float y = d.y + sa * sc.x + vv * sc.y;
                const bf16x8 bu = __builtin_bit_cast(bf16x8, (v4u){pk2c(sa, vv) & m0, 0u, 0u, 0u});
                S0 = __builtin_amdgcn_mfma_f32_16x16x32_bf16(__builtin_bit_cast(bf16x8, (v4u){k_0 & m0, 0u, 0u, 0u}), bu, S0 * w_0, 0, 0, 0);
                S1 = __builtin_amdgcn_mfma_f32_16x16x32_bf16(__builtin_bit_cast(bf16x8, (v4u){k_1 & m0, 0u, 0u, 0u}), bu, S1 * w_1, 0, 0, 0);
                S2 = __builtin_amdgcn_mfma_f32_16x16x32_bf16(__builtin_bit_cast(bf16x8, (v4u){k_2 & m0, 0u, 0u, 0u}), bu, S2 * w_2, 0, 0, 0);
                S3 = __builtin_amdgcn_mfma_f32_16x16x32_bf16(__builtin_bit_cast(bf16x8, (v4u){k_3 & m0, 0u, 0u, 0u}), bu, S3 * w_3, 0, 0, 0);
                if (fq == 0) Yb[t * 64] = y;
                w_0 = nw_0; w_1 = nw_1; w_2 = nw_2; w_3 = nw_3; k_0 = nk_0; k_1 = nk_1; k_2 = nk_2; k_3 = nk_3; a00 = na00; a01 = na01; a10 = na10; a11 = na11; vv = nvv; sc = nsc;
            }
#undef RW_LD
            __syncthreads();
        }
        float* so = C.out + (sample ? O_WKVS : O_WKVP) + ((((size_t)l * 8 + b) * 16 + h) * 64 + row) * 64 + 4 * fq;
        *(f32x4*)so = S0; *(f32x4*)(so + 16) = S1; *(f32x4*)(so + 32) = S2; *(f32x4*)(so + 48) = S3;
    } else {
        const int pw = w - 4, tl = lane >> 4, sub = lane & 15, ch0 = 4 * sub, fr = lane & 15, fq = lane >> 4;
        LAS bf16* XLw = (LAS bf16*)(L + RW_XL + pw * 2176);
        LAS float* ZR = (LAS float*)(L + RW_ZR + pw * 3072);
        LAS bf16* LW0 = (LAS bf16*)(L + RW_LW); LAS bf16* LW1 = LW0 + 64 * 72; LAS bf16* LW2 = LW1 + 64 * 72;
        { const int pt = pw * 64 + lane;
          for (int i = pt; i < 64 * 8; i += 256) { const int n = i >> 3, kc = i & 7;
              *(LAS v4u*)(LW0 + n * 72 + kc * 8) = *(const v4u*)((const bf16*)(C.ws + WS_W2T) + (size_t)(h * 64 + n) * 64 + kc * 8);
              *(LAS v4u*)(LW1 + n * 72 + kc * 8) = *(const v4u*)((const bf16*)(C.ws + WS_A2T) + (size_t)(h * 64 + n) * 64 + kc * 8); }
          for (int i = pt; i < 64 * 16; i += 256) { const int n = i >> 4, kc = i & 15;
              *(LAS v4u*)(LW2 + n * 136 + kc * 8) = *(const v4u*)((const bf16*)(C.ws + WS_G2T) + (size_t)(h * 64 + n) * 128 + kc * 8); } }
        const int gc = h * 64 + ch0;
        const f32x4 cw0 = *(const f32x4*)(C.in[14] + (size_t)l * DM + gc), ca0 = *(const f32x4*)(C.in[16] + (size_t)l * DM + gc), ckk = *(const f32x4*)(C.in[19] + (size_t)l * DM + gc),
                    cka = *(const f32x4*)(C.in[20] + (size_t)l * DM + gc), crk = *(const f32x4*)(C.in[21] + (size_t)l * DM + gc), clg = *(const f32x4*)(C.in[22] + (size_t)l * DM + gc),
                    clb = *(const f32x4*)(C.in[23] + (size_t)l * DM + gc);
        LAS float* MU = (LAS float*)(L + RW_MU);
        { const float* mu = C.in[13] + (size_t)l * RC; const int pt = pw * 64 + lane;
          for (int i = pt; i < 448; i += 256) { const int q = i >> 3, e = i & 7; const int col = q < 8 ? h * 64 + q * 8 : q < 16 ? 1024 + h * 64 + (q - 8) * 8 : q < 24 ? 2048 + h * 64 + (q - 16) * 8 : 3072 + (q - 24) * 8; MU[i] = mu[col + e]; MU[448 + i] = sample ? C.in[5][((size_t)l * 8 + b) * RC + col + e] : 0.f; } }
        RawRegs rA, rB;
        const bf16* PRu = PR + rowbase * RC;
        int ioff[4], itl[4], iq[4];
        { itl[0] = lane / 24; iq[0] = lane % 24;
          if (lane < 32) { itl[1] = (64 + lane) / 24; iq[1] = (64 + lane) % 24; } else { itl[1] = (lane - 32) >> 3; iq[1] = 32 + ((lane - 32) & 7); }
          itl[2] = (lane & 31) >> 3; iq[2] = 24 + (lane & 7);
          itl[3] = lane >> 4; iq[3] = 40 + (lane & 15);
#pragma unroll
          for (int j = 0; j < 4; ++j) { const int q = iq[j]; const int col = q < 8 ? h * 64 + q * 8 : q < 16 ? 1024 + h * 64 + (q - 8) * 8 : q < 24 ? 2048 + h * 64 + (q - 16) * 8 : 3072 + (q - 24) * 8;
              ioff[j] = (4 * pw + itl[j]) * RC + col; } }
        rw_issue(rA, PRu, T, 0, pw, ioff, itl);
        __syncthreads();
#define RW_BODY(c, rcur, FIRST) do { \
            if ((c) >= 1) { const int cp = (c) - 1, tok = 4 * pw + tl; \
                const f32x4 y = *(const LAS f32x4*)(L + RW_YC + (cp & 1) * 4096 + (tok * 64 + ch0) * 4); \
                const LAS unsigned char* Pb = L + RW_POST + (cp % 3) * 8320; \
                const f32x4 g = *(const LAS f32x4*)(Pb + (tok * 64 + ch0) * 4), v = *(const LAS f32x4*)(Pb + 4096 + (tok * 64 + ch0) * 4); const float bon = *(const LAS float*)(Pb + 8192 + tok * 4); \
                const float mean = row16_sum((y.x + y.y) + (y.z + y.w)) * (1.f / 64.f); const f32x4 d = y - mean; \
                const float var = row16_sum((d.x * d.x + d.y * d.y) + (d.z * d.z + d.w * d.w)) * (1.f / 64.f); const float rstd = __builtin_amdgcn_rsqf(var + 64e-5f); \
                const f32x4 o = (d * rstd * clg + clb + v * bon) * g; \
                v2u ow; ow.x = pk2(o.x, o.y); ow.y = pk2(o.z, o.w); \
                *(v2u*)(Yg + (rowbase + cp * 16 + tok) * DM + gc) = ow; } \
            const int cn = (c) + 1; \
            if (cn < NC) { \
                LAS float* Mb = (LAS float*)(L + RW_MAIN + (cn & 1) * RW_MSTR); LAS float* Pf = (LAS float*)(L + RW_POST + (cn % 3) * 8320); \
_Pragma("unroll") \
                for (int j = 0; j < 4; ++j) { const int t4 = itl[j], q = iq[j]; const int t = cn * 16 + 4 * pw + t4; \
                    { const int col = q < 8 ? h * 64 + q * 8 : q < 16 ? 1024 + h * 64 + (q - 8) * 8 : q < 24 ? 2048 + h * 64 + (q - 16) * 8 : 3072 + (q - 24) * 8; \
                        float cur[8], prv[8]; unpack8(rcur.cur[j], cur); unpack8(rcur.prv[j], prv); \
                        if (FIRST && t == 0) { const f32x4 x0 = *(const LAS f32x4*)(MU + 448 + q * 8), x1 = *(const LAS f32x4*)(MU + 452 + q * 8); \
                            prv[0] = x0.x; prv[1] = x0.y; prv[2] = x0.z; prv[3] = x0.w; prv[4] = x1.x; prv[5] = x1.y; prv[6] = x1.z; prv[7] = x1.w; } \
                        const f32x4 m0 = *(const LAS f32x4*)(MU + q * 8), m1 = *(const LAS f32x4*)(MU + q * 8 + 4); \
                        const float mm[8] = {m0.x, m0.y, m0.z, m0.w, m1.x, m1.y, m1.z, m1.w}; float mx[8]; \
_Pragma("unroll") \
                        for (int e = 0; e < 8; ++e) mx[e] = cur[e] + (prv[e] - cur[e]) * mm[e]; \
                        const int tok = 4 * pw + t4; \
                        if (q < 24) { LAS float* dst = (q < 8 ? Mb : q < 16 ? Mb + 1024 : Pf + 1024) + tok * 64 + (q & 7) * 8; \
                            *(LAS f32x4*)dst = (f32x4){mx[0], mx[1], mx[2], mx[3]}; *(LAS f32x4*)(dst + 4) = (f32x4){mx[4], mx[5], mx[6], mx[7]}; } \
                        else { float o[8]; \
                            if (q < 32) { \
_Pragma("unroll") \
                                for (int e = 0; e < 8; ++e) { const float ex = __expf(2.0f * mx[e]); o[e] = 1.0f - 2.0f * __builtin_amdgcn_rcpf(ex + 1.0f); } } \
                            else if (q < 40) { \
_Pragma("unroll") \
                                for (int e = 0; e < 8; ++e) o[e] = mx[e]; } \
                            else { \
_Pragma("unroll") \
                                for (int e = 0; e < 8; ++e) o[e] = pg8::fast_sigmoid(mx[e]); } \
                            *(LAS v4u*)(XLw + t4 * 264 + (q - 24) * 8) = pack8(o); } } } \
                asm volatile("" ::: "memory"); \
_Pragma("unroll") \
                for (int mat = 0; mat < 3; ++mat) { const int KK = mat == 2 ? 128 : 64, xoff = mat * 64, st = mat == 2 ? 136 : 72; const LAS bf16* LWm = mat == 0 ? LW0 : mat == 1 ? LW1 : LW2; \
_Pragma("unroll") \
                    for (int nt = 0; nt < 4; ++nt) { f32x4 acc = (f32x4){0.f, 0.f, 0.f, 0.f}; \
_Pragma("unroll") \
                        for (int k2 = 0; k2 < KK / 32; ++k2) { const bf16x8 wf = *(const LAS bf16x8*)(LWm + (nt * 16 + fr) * st + k2 * 32 + fq * 8); \
                            const bf16x8 xf = *(const LAS bf16x8*)(XLw + (fr & 3) * 264 + xoff + k2 * 32 + fq * 8); \
                            acc = __builtin_amdgcn_mfma_f32_16x16x32_bf16(wf, xf, acc, 0, 0, 0); } \
                        if (fr < 4) *(LAS f32x4*)(ZR + mat * 256 + fr * 64 + nt * 16 + 4 * fq) = acc; } } \
                asm volatile("" ::: "memory"); \
                { const int tok = 4 * pw + tl; \
                  const f32x4 z = *(const LAS f32x4*)(ZR + tl * 64 + ch0), ar = *(const LAS f32x4*)(ZR + 256 + tl * 64 + ch0), g = *(const LAS f32x4*)(ZR + 512 + tl * 64 + ch0); \
                  const f32x4 k = *(const LAS f32x4*)(Mb + 1024 + tok * 64 + ch0), r = *(const LAS f32x4*)(Mb + tok * 64 + ch0); \
                  f32x4 wd, a; \
_Pragma("unroll") \
                  for (int e = 0; e < 4; ++e) { wd[e] = __expf(-0.60653066f * pg8::fast_sigmoid(cw0[e] + z[e])); a[e] = pg8::fast_sigmoid(ca0[e] + ar[e]); } \
                  const f32x4 kk = k * ckk; const float ss = row16_sum((kk.x * kk.x + kk.y * kk.y) + (kk.z * kk.z + kk.w * kk.w)); \
                  const float inv = __builtin_amdgcn_rsqf(fmaxf(ss, 1e-24f)); const f32x4 kn = kk * inv; const f32x4 kp = k * (1.0f + (a - 1.0f) * cka); \
                  const f32x4 rb = r * kp * crk; const float bon = row16_sum((rb.x + rb.y) + (rb.z + rb.w)); \
                  const f32x4 bq = kn * a; const f32x4 t1 = bq * r, t2 = kp * r; const float br = row16_sum((t1.x + t1.y) + (t1.z + t1.w)), kr = row16_sum((t2.x + t2.y) + (t2.z + t2.w)); *(LAS f32x4*)(Mb + tok * 64 + ch0) = wd * r; if (sub == 0) *(LAS f32x2*)(Mb + 5120 + tok * 2) = (f32x2){br, kr}; *(LAS f32x4*)(Mb + 2048 + tok * 64 + ch0) = wd; { const f32x4 wr_ = wd * r; LAS bf16* ab = (LAS bf16*)(Mb + 3072); v2u pa, pq; pa.x = pk2(-kn.x, -kn.y); pa.y = pk2(-kn.z, -kn.w); pq.x = pk2(wr_.x, wr_.y); pq.y = pk2(wr_.z, wr_.w); *(LAS v2u*)(ab + tok * 64 + ch0) = pa; *(LAS v2u*)(ab + 1024 + tok * 64 + ch0) = pq; } *(LAS v4u*)((LAS unsigned*)(Mb + 4096) + tok * 64 + ch0) = (v4u){pk2(bq.x, kp.x), pk2(bq.y, kp.y), pk2(bq.z, kp.z), pk2(bq.w, kp.w)}; \
                  *(LAS f32x4*)(Pf + tok * 64 + ch0) = g; if (sub == 0) Pf[2048 + tok] = bon; } \
            } \
        } while (0)
        rw_issue(rB, PRu, T, 1, pw, ioff, itl);
        RW_BODY(-1, rA, true);
        __syncthreads();
        for (int c2 = 0; c2 < NC; c2 += 2) {
            if (!sample && c2 == 142) {
                if (lane == 0) { unsigned sp = 0; while (__hip_atomic_load((const unsigned*)C.ws + 32, __ATOMIC_RELAXED, __HIP_MEMORY_SCOPE_AGENT) < 128u * (unsigned)(l + 1) && ++sp < (1u << 24)) __builtin_amdgcn_s_sleep(4); }
                __builtin_amdgcn_fence(__ATOMIC_ACQUIRE, "agent"); asm volatile("s_waitcnt vmcnt(0)" ::: "memory"); }
            rw_issue(rA, PRu, T, c2 + 2, pw, ioff, itl);
            RW_BODY(c2, rB, false);
            __syncthreads();
            rw_issue(rB, PRu, T, c2 + 3, pw, ioff, itl);
            RW_BODY(c2 + 1, rA, false);
            __syncthreads();
        }
#undef RW_BODY
        { const int cp = NC - 1, tok = 4 * pw + tl;
          const f32x4 y = *(const LAS f32x4*)(L + RW_YC + (cp & 1) * 4096 + (tok * 64 + ch0) * 4);
          const LAS unsigned char* Pb = L + RW_POST + (cp % 3) * 8320;
          const f32x4 g = *(const LAS f32x4*)(Pb + (tok * 64 + ch0) * 4), v = *(const LAS f32x4*)(Pb + 4096 + (tok * 64 + ch0) * 4); const float bon = *(const LAS float*)(Pb + 8192 + tok * 4);
          const float mean = row16_sum((y.x + y.y) + (y.z + y.w)) * (1.f / 64.f); const f32x4 d = y - mean;
          const float var = row16_sum((d.x * d.x + d.y * d.y) + (d.z * d.z + d.w * d.w)) * (1.f / 64.f); const float rstd = __builtin_amdgcn_rsqf(var + 64e-5f);
          const f32x4 o = (d * rstd * clg + clb + v * bon) * g;
          v2u ow; ow.x = pk2(o.x, o.y); ow.y = pk2(o.z, o.w);
          *(v2u*)(Yg + (rowbase + cp * 16 + tok) * DM + gc) = ow; }
    }
    __syncthreads();
}
__device__ __forceinline__ void rwkv_phase(const Ctx& C, int l, bool aux, int csub) {
    { const int s = aux ? 1 : 0, r = csub & 127;
      Ctx C2 = C; { int t_ = C.tid; asm volatile("" : "+v"(t_)); C2.tid = t_; C2.lane = t_ & 63; C2.wave = __builtin_amdgcn_readfirstlane(t_ >> 6); }
      rwkv_unit(C2, l, s, r >> 4, r & 15); }
    if (!aux) { const bf16* PR = (const bf16*)(C.ws + WS_BIG);
      for (int i = blockIdx.x * NT + C.tid; i < 16 * RC; i += 128 * NT) { const int bb = i / RC, c = i % RC;
        const size_t row = bb < 8 ? (size_t)bb * SEQ + SEQ - 1 : (size_t)MP + (size_t)(bb - 8) * DECS + DECS - 1;
        const float v = __uint_as_float((unsigned)PR[row * RC + c] << 16);
        C.out[(bb < 8 ? O_SHP : O_SHS) + ((size_t)l * 8 + (bb & 7)) * RC + c] = v; } }
}

__device__ __forceinline__ void sgu_phase(const Ctx& C, int l, int csub, int gsub) {
    const bf16* UV = (const bf16*)(C.ws + WS_UVB); bf16* Yg = (bf16*)(C.ws + WS_UVB); const bf16* WS = (const bf16*)(C.ws + WS_WS);
    const float* lng = C.in[24] + (size_t)l * DM; const float* lnb = C.in[25] + (size_t)l * DM; const float* bs = C.in[27] + (size_t)l * 8 * 128;
    LAS float* stat = (LAS float*)C.lds;
    const int lane = C.lane, w = C.wave, fr = lane & 15, fq = lane >> 4;
    LAS bf16* VT = (LAS bf16*)(C.lds + 1024 + w * 8704);
    for (int u = csub; u < 520; u += gsub) {
        const int sample = u >= 512; const int nrows = sample ? 32 : 128;
        const size_t row0 = sample ? (size_t)MP + (size_t)(u - 512) * DECS : (size_t)u * 128;
        for (int tk = w * 16; tk < w * 16 + 16; ++tk) {
            if (tk < nrows) {
                const bf16* vp = UV + (row0 + tk) * 2048 + 1024 + lane * 16; float x[16];
                unpack8(*(const v4u*)vp, x); unpack8(*(const v4u*)(vp + 8), x + 8);
                float s = 0.f;
#pragma unroll
                for (int e = 0; e < 16; ++e) s += x[e];
                const float mean = wave_sum(s) * (1.f / 1024.f); float q = 0.f;
#pragma unroll
                for (int e = 0; e < 16; ++e) { x[e] -= mean; q += x[e] * x[e]; }
                const float rstd = 1.0f / sqrtf(wave_sum(q) * (1.f / 1024.f) + 1e-5f);
                if (lane == 0) { stat[tk * 2] = mean; stat[tk * 2 + 1] = rstd; }
                if (sample) { float* op = C.out + O_SGUV + (((size_t)l * 8 + (u - 512)) * DECS + tk) * DM + lane * 16;
#pragma unroll
                    for (int e4 = 0; e4 < 4; ++e4) { const f32x4 gg = *(const f32x4*)(lng + lane * 16 + e4 * 4), bb = *(const f32x4*)(lnb + lane * 16 + e4 * 4);
                        f32x4 o; o.x = x[e4 * 4] * rstd * gg.x + bb.x; o.y = x[e4 * 4 + 1] * rstd * gg.y + bb.y; o.z = x[e4 * 4 + 2] * rstd * gg.z + bb.z; o.w = x[e4 * 4 + 3] * rstd * gg.w + bb.w;
                        *(f32x4*)(op + e4 * 4) = o; } }
            }
        }
        __syncthreads();
        const int g = w;
        for (int q4 = 0; q4 < 4; ++q4) {
            const int c0 = g * 128 + q4 * 32;
            { const int cl = lane & 3, jl = lane >> 2; float gg[8], bb[8];
#pragma unroll
              for (int e = 0; e < 8; ++e) { gg[e] = lng[c0 + cl * 8 + e]; bb[e] = lnb[c0 + cl * 8 + e]; }
#pragma unroll
              for (int p = 0; p < 8; ++p) { const int j = p * 16 + jl; float x[8];
                  if (j < nrows) { unpack8(*(const v4u*)(UV + (row0 + j) * 2048 + 1024 + c0 + cl * 8), x); const float mean = stat[j * 2], rstd = stat[j * 2 + 1];
#pragma unroll
                      for (int e = 0; e < 8; ++e) x[e] = (x[e] - mean) * rstd * gg[e] + bb[e]; }
                  else {
#pragma unroll
                      for (int e = 0; e < 8; ++e) x[e] = 0.f; }
#pragma unroll
                  for (int e = 0; e < 8; ++e) VT[(cl * 8 + e) * 136 + j] = (bf16)f2bf(x[e]); } }
            LDS_WAIT(); __builtin_amdgcn_wave_barrier();
            const int nit = nrows / 16;
            for (int it = 0; it < nit; ++it) {
                f32x4 acc0 = (f32x4){0.f, 0.f, 0.f, 0.f}, acc1 = acc0;
                for (int k2 = 0; k2 <= (it >> 1); ++k2) {
                    const bf16x8 wf = *(const bf16x8*)(WS + ((size_t)g * 128 + it * 16 + fr) * 128 + k2 * 32 + fq * 8);
                    const bf16x8 v0 = *(const LAS bf16x8*)(VT + (fr) * 136 + k2 * 32 + fq * 8);
                    const bf16x8 v1 = *(const LAS bf16x8*)(VT + (16 + fr) * 136 + k2 * 32 + fq * 8);
                    acc0 = __builtin_amdgcn_mfma_f32_16x16x32_bf16(v0, wf, acc0, 0, 0, 0);
                    acc1 = __builtin_amdgcn_mfma_f32_16x16x32_bf16(v1, wf, acc1, 0, 0, 0);
                }
                const int i = it * 16 + fr; const float bsi = bs[g * 128 + i];
#pragma unroll
                for (int ct = 0; ct < 2; ++ct) { const f32x4 a = ct ? acc1 : acc0; const int c = c0 + ct * 16 + fq * 4;
                    const v2u uu = *(const v2u*)(UV + (row0 + i) * 2048 + c);
                    v2u o; o.x = pk2(bflo(uu.x) * (a.x + bsi), bfhi(uu.x) * (a.y + bsi)); o.y = pk2(bflo(uu.y) * (a.z + bsi), bfhi(uu.y) * (a.w + bsi));
                    *(v2u*)(Yg + (row0 + i) * 2048 + c) = o; }
            }
            LDS_WAIT(); __builtin_amdgcn_wave_barrier();
        }
        __syncthreads();
    }
}

__device__ __forceinline__ void attn_phase(const Ctx& C, int csub, int gsub) {
    const bf16* Q = (const bf16*)(C.ws + WS_UVB) + 1024; bf16* Yg = (bf16*)(C.ws + WS_UVB) + 1024;
    const bf16* KB = (const bf16*)(C.ws + WS_KB); const bf16* VT = (const bf16*)(C.ws + WS_VT);
    const int lane = C.lane, w = C.wave, fr = lane & 15, fq = lane >> 4, tid = C.tid;
    LAS bf16* KL = (LAS bf16*)C.lds;
    for (int u = csub; u < 1024 + 32; u += gsub) {
        int bb, h, nqt; size_t rowq;
        if (u < 1024) { const int rb = u >> 2; h = u & 3; bb = rb >> 5; rowq = (size_t)rb * 256 + w * 32; nqt = 2; }
        else { const int su = u - 1024; h = su & 3; bb = 8 + (su >> 2); rowq = (size_t)MP + (size_t)(su >> 2) * DECS + w * 16; nqt = w < 2 ? 1 : 0; }
        const bf16* Kp = KB + (size_t)bb * 262144 + h * 256; const bf16* Vp = VT + ((size_t)bb * 4 + h) * 65536;
        __syncthreads();
#pragma unroll 4
        for (int i = tid; i < 8192; i += NT) { const int m = i >> 5, ch = i & 31; *(LAS v4u*)(KL + m * 264 + ch * 8) = *(const v4u*)(Kp + (size_t)m * 1024 + ch * 8); }
        __syncthreads();
        bf16x8 pf[2][8]; float rs[2];
#pragma unroll
        for (int j = 0; j < 2; ++j) {
            rs[j] = 0.f;
#pragma unroll
            for (int k2 = 0; k2 < 8; ++k2) pf[j][k2] = (bf16x8){0, 0, 0, 0, 0, 0, 0, 0};
            if (j < nqt) {
                const size_t row0 = rowq + j * 16;
                bf16x8 qf[8];
#pragma unroll
                for (int k2 = 0; k2 < 8; ++k2) qf[k2] = *(const bf16x8*)(Q + (row0 + fr) * 2048 + h * 256 + k2 * 32 + fq * 8);
                f32x4 s[16];
#pragma unroll
                for (int mt = 0; mt < 16; ++mt) { f32x4 acc = (f32x4){0.f, 0.f, 0.f, 0.f};
#pragma unroll
                    for (int k2 = 0; k2 < 8; ++k2) { const bf16x8 kf = *(const LAS bf16x8*)(KL + (mt * 16 + fr) * 264 + k2 * 32 + fq * 8);
                        acc = __builtin_amdgcn_mfma_f32_16x16x32_bf16(kf, qf[k2], acc, 0, 0, 0); }
                    s[mt] = acc; }
                float mx = -3.0e38f;
#pragma unroll
                for (int mt = 0; mt < 16; ++mt) mx = fmaxf(mx, fmaxf(fmaxf(s[mt].x, s[mt].y), fmaxf(s[mt].z, s[mt].w)));
                mx = fmaxf(mx, __shfl_xor(mx, 16)); mx = fmaxf(mx, __shfl_xor(mx, 32));
                float sum = 0.f;
#pragma unroll
                for (int mt = 0; mt < 16; ++mt) {
#pragma unroll
                    for (int e = 0; e < 4; ++e) { const float p = __expf((s[mt][e] - mx) * 0.0625f); s[mt][e] = p; sum += p; } }
                sum += __shfl_xor(sum, 16); sum += __shfl_xor(sum, 32);
                rs[j] = 1.0f / sum;
#pragma unroll
                for (int k2 = 0; k2 < 8; ++k2) { v4u pw; pw.x = pk2(s[2 * k2].x, s[2 * k2].y); pw.y = pk2(s[2 * k2].z, s[2 * k2].w); pw.z = pk2(s[2 * k2 + 1].x, s[2 * k2 + 1].y); pw.w = pk2(s[2 * k2 + 1].z, s[2 * k2 + 1].w);
                    pf[j][k2] = __builtin_bit_cast(bf16x8, pw); }
            }
        }
        __syncthreads();
#pragma unroll 4
        for (int i = tid; i < 8192; i += NT) { const int d = i >> 5, ch = i & 31; *(LAS v4u*)(KL + d * 264 + ch * 8) = *(const v4u*)(Vp + (size_t)d * 256 + ch * 8); }
        __syncthreads();
#pragma unroll
        for (int j = 0; j < 2; ++j) {
            if (j < nqt) {
                const size_t row0 = rowq + j * 16;
#pragma unroll 2
                for (int dt = 0; dt < 16; ++dt) { f32x4 acc = (f32x4){0.f, 0.f, 0.f, 0.f};
#pragma unroll
                    for (int k2 = 0; k2 < 8; ++k2) { const bf16x8 vf = *(const LAS bf16x8*)(KL + (dt * 16 + fr) * 264 + k2 * 32 + fq * 8);
                        acc = __builtin_amdgcn_mfma_f32_16x16x32_bf16(vf, pf[j][k2], acc, 0, 0, 0); }
                    v2u o; o.x = pk2(acc.x * rs[j], acc.y * rs[j]); o.y = pk2(acc.z * rs[j], acc.w * rs[j]);
                    *(v2u*)(Yg + (row0 + fr) * 2048 + h * 256 + dt * 16 + fq * 4) = o; }
            }
        }
    }
    __syncthreads();
}

__device__ __forceinline__ void final_norm(const Ctx& C) {
    float* X = C.out; const float* g = C.in[10];
    for (int r = C.gw; r < M; r += C.ngw) {
        f32x4* xr = (f32x4*)(X + (size_t)r * DM) + C.lane; const f32x4* gr = (const f32x4*)g + C.lane;
        f32x4 v[4]; float s = 0.f;
#pragma unroll
        for (int j = 0; j < 4; ++j) { v[j] = xr[64 * j]; s += (v[j].x * v[j].x + v[j].y * v[j].y) + (v[j].z * v[j].z + v[j].w * v[j].w); }
        const float rr = 1.0f / sqrtf(wave_sum(s) * (1.f / DM) + 1e-6f);
#pragma unroll
        for (int j = 0; j < 4; ++j) xr[64 * j] = v[j] * rr * gr[64 * j];
    }
}

__device__ __forceinline__ void small_gemm(const Ctx& C, int csub, int gsub, const bf16* A, int lda, const bf16* Bt, int N, int K, int mode, bf16* O, const bf16* T, float* X, int ldc, int first) {
    const int lane = C.lane, w = C.wave, fr = lane & 15, fq = lane >> 4;
    const int nit = 8 * (N >> 6);
    for (int it = csub; it < nit; it += gsub) {
        const int rg = it & 7, cg = it >> 3;
        const size_t row = (size_t)MP + rg * 32 + (w & 1) * 16 + fr; const int colb = cg * 64 + (w >> 1) * 16;
        const bf16* ap = A + row * lda + fq * 8; const bf16* bp = Bt + (size_t)(colb + fr) * K + fq * 8;
        f32x4 acc = (f32x4){0.f, 0.f, 0.f, 0.f};
#pragma unroll 16
        for (int k2 = 0; k2 < (K >> 5); ++k2) { const bf16x8 af = *(const bf16x8*)(ap + k2 * 32), bf = *(const bf16x8*)(bp + k2 * 32);
            acc = __builtin_amdgcn_mfma_f32_16x16x32_bf16(bf, af, acc, 0, 0, 0); }
        const size_t off = row * ldc + colb + 4 * fq;
        if (mode == 4) { f32x4* p = (f32x4*)(X + off); *p = *p + acc; }
        else { f32x4 v = acc;
            if (mode == 1) {
#pragma unroll
                for (int e = 0; e < 4; ++e) v[e] = pg8::gelu_tanh(v[e]); }
            else if (mode == 2) {
#pragma unroll
                for (int e = 0; e < 4; ++e) { const float r = fmaxf(v[e], 0.f); v[e] = r * r; } }
            else if (mode == 3) { const v2u t = *(const v2u*)(T + off); v2u g = (v2u){0u, 0u}; if (!first) g = *(const v2u*)(O + off);
                v[0] = bflo(g.x) + pg8::fast_sigmoid(v[0]) * bflo(t.x); v[1] = bfhi(g.x) + pg8::fast_sigmoid(v[1]) * bfhi(t.x);
                v[2] = bflo(g.y) + pg8::fast_sigmoid(v[2]) * bflo(t.y); v[3] = bfhi(g.y) + pg8::fast_sigmoid(v[3]) * bfhi(t.y); }
            v2u o; o.x = pk2(v[0], v[1]); o.y = pk2(v[2], v[3]); *(v2u*)(O + off) = o; }
    }
}

#ifndef PH_LO
#define PH_LO 0
#endif
#ifndef PH_HI
#define PH_HI 1000
#endif
__global__ void __launch_bounds__(NT, 2) mega_fwd(Args args) {
    extern __shared__ __attribute__((aligned(16))) unsigned char lds_raw[];
    cg::grid_group grid = cg::this_grid();
    const int G = gridDim.x, cb = blockIdx.x;
    typedef pg8::bf16_t pb;
    constexpr int NSTEP = 2 + 16 * DEPTH + 1;
    const bool aux = blockIdx.x >= 128; const int csub = aux ? (int)blockIdx.x - 128 : (int)blockIdx.x;
    unsigned* const subcnt = (unsigned*)args.ws;
    int nbar = 0;
    bool second = false;
    if (blockIdx.x == 0 && threadIdx.x < 128) ((unsigned*)args.ws)[threadIdx.x] = 0u;
    for (int step = PH_LO; step < NSTEP && step < PH_HI; ++step) {
        Ctx C; { int z_ = 0, t_ = threadIdx.x; asm volatile("" : "+s"(z_), "+v"(t_));
                 C.in = args.in + z_; C.out = args.out + z_; C.ws = args.ws + z_; C.lds = (LAS unsigned char*)lds_raw; C.tid = t_; C.lane = t_ & 63; C.wave = __builtin_amdgcn_readfirstlane(t_ >> 6);
                 C.gw = blockIdx.x * NWAVES + C.wave; C.ngw = gridDim.x * NWAVES; }
        int l = 0, ls = -1;
        if (step >= 2 && step < 2 + 16 * DEPTH) { l = (step - 2) / 16; ls = (step - 2) % 16; }
        int gm = -1, gN = 0, gK = DM, gM = MP, ldc = 0, lda = DM, first = 0, memkv = 0, gG = G, gc = cb, half = 0; size_t aoff = 0, boff = 0, ooff = 0, toff = 0; bool sync = true;
        if (step == 1) { gm = 5; gM = 8192; gN = 8192; aoff = WS_AMEM; boff = WS_WMKV; memkv = 1; }
        switch (ls) {
            case 1: gm = 0; gN = RC; aoff = WS_H; boff = WS_WIN; ooff = WS_BIG; ldc = RC; gM = 8 * 9 * 256; half = 1; break;
            case 2: if (aux) { gG = 128; gc = csub;
                        if (!second) { gm = 0; gN = RC; aoff = WS_H; boff = WS_WIN; ooff = WS_BIG; ldc = RC; gM = 8 * 23 * 256; half = 2; }
                        else { gm = 1; gN = 2048; aoff = WS_H; boff = WS_WIN + (size_t)COL_GMLP * DM * 2; ooff = WS_UVB; ldc = 2048; } } sync = false; break;
            case 3: sync = false; break;
            case 4: if (aux) { gm = 0; gN = DM; aoff = WS_H; boff = WS_WIN + (size_t)COL_Q * DM * 2; ooff = WS_UVB + 2048; ldc = 2048; gG = 128; gc = csub; } sync = false; break;
            case 6: gm = 0; gN = DM; aoff = WS_Y; boff = WS_WB; ooff = WS_T2; ldc = DM; sync = false; break;
            case 7: gm = 3; gN = DM; aoff = WS_H; boff = WS_WIN + (size_t)COL_GATE * DM * 2; ooff = WS_MG2; toff = WS_T2; ldc = DM; first = 1; sync = false; break;
            case 8: gm = 0; gN = DM; aoff = WS_UVB; lda = 2048; boff = WS_WB + (size_t)DM * DM * 2; ooff = WS_T2; ldc = DM; sync = false; break;
            case 9: gm = 3; gN = DM; aoff = WS_H; boff = WS_WIN + (size_t)(COL_GATE + DM) * DM * 2; ooff = WS_MG2; toff = WS_T2; ldc = DM; sync = false; break;
            case 10: gm = 0; gN = DM; aoff = WS_UVB + 2048; lda = 2048; boff = WS_WB + 2 * (size_t)DM * DM * 2; ooff = WS_T2; ldc = DM; sync = false; break;
            case 11: gm = 3; gN = DM; aoff = WS_H; boff = WS_WIN + (size_t)(COL_GATE + 2 * DM) * DM * 2; ooff = WS_MG2; toff = WS_T2; ldc = DM; break;
            case 12: gm = 4; gN = DM; aoff = WS_MG2; boff = WS_WOUT; ldc = DM; break;
            case 14: gm = 2; gN = DFF; aoff = WS_H; boff = WS_WUP; ooff = WS_UP; ldc = DFF; break;
            case 15: gm = 4; gN = DM; gK = DFF; lda = DFF; aoff = WS_UP; boff = WS_WDN; ldc = DM; break;
            default: break;
        }
        if (gm >= 0) {
            pg8::Gemm g_{(const pb*)(C.ws + aoff), (const pb*)(C.ws + boff), gM, gN, gK, lda};
            pg8::OrderU S_; S_.so.init(gM, gN, gG, gc); S_.memkv = memkv; S_.half = half;
            pg8::EpiU E_{gm, gm <= 3, (pb*)(C.ws + ooff), (const pb*)(C.ws + toff), gm == 5 ? C.out + O_MK : C.out, C.out + O_MV, ldc, first};
            pg8::gemm_phase<pg8::EpiU, pg8::OrderU, true, true>(C.lds, g_, S_, E_);
            if (half == 2) {
                asm volatile("s_waitcnt vmcnt(0)" ::: "memory"); __syncthreads();
                if (threadIdx.x == 0) { __builtin_amdgcn_fence(__ATOMIC_RELEASE, "agent"); asm volatile("s_waitcnt vmcnt(0)" ::: "memory"); __hip_atomic_fetch_add(subcnt + 32, 1u, __ATOMIC_RELAXED, __HIP_MEMORY_SCOPE_AGENT); }
            } else if (!memkv) small_gemm(C, gc, gG, (const bf16*)(C.ws + aoff), lda, (const bf16*)(C.ws + boff), gN, gK, gm, (bf16*)(C.ws + ooff), (const bf16*)(C.ws + toff), C.out, ldc, first);
        }
        else if (step == 0 || ls == 0 || ls == 13) prep_phase(C, step == 0 ? -1 : ls == 0 ? l : -2, l);
        else if (step == NSTEP - 1) { final_norm(C); sync = false; }
        else if ((ls == 2 && !aux) || (ls == 3 && aux)) { rwkv_phase(C, l, aux, csub); if (aux) sgu_phase(C, l, csub, 128); }
        else if (ls == 5 && aux) attn_phase(C, csub, 128);
        if (aux && ls == 2 && !second) { second = true; --step; continue; }
        second = false;
        if (aux && ls >= 2 && ls <= 4) sub_barrier(subcnt, 128u * (unsigned)(l * 3 + (ls - 1)));
        if (sync) { if (step == 0) grid.sync();
                    else sub_barrier(subcnt + 64, (unsigned)G * (unsigned)(++nbar)); }
    }
}

extern "C" void kernel_launch(void* const* d_in, const int* in_sizes, int n_in, void* d_out, int out_size, void* d_ws, size_t ws_size, hipStream_t stream) {
    static int grid = 0;
    if (grid == 0) {
        if (n_in != 32 || (size_t)out_size != O_END || ws_size < WS_END) { fprintf(stderr, "kernel_launch: unexpected shapes n_in %d out %d ws %zu (need %zu)\n", n_in, out_size, ws_size, (size_t)WS_END); grid = -1; return; }
        int dev = 0, cus = 0, per_cu = 0;
        hipGetDevice(&dev); hipDeviceGetAttribute(&cus, hipDeviceAttributeMultiprocessorCount, dev);
        hipFuncSetAttribute((const void*)mega_fwd, hipFuncAttributeMaxDynamicSharedMemorySize, LDS_BYTES);
        hipOccupancyMaxActiveBlocksPerMultiprocessor(&per_cu, (const void*)mega_fwd, NT, LDS_BYTES);
        (void)hipGetLastError();
        if (per_cu < 1) per_cu = 1;
        grid = 256;
        if (cus < 256) { fprintf(stderr, "kernel_launch: needs 256 CUs, device has %d\n", cus); grid = -1; return; }
    }
    if (grid < 0) return;
    Args a{};
    for (int i = 0; i < 32; ++i) a.in[i] = (const float*)d_in[i];
    a.out = (float*)d_out; a.ws = (unsigned char*)d_ws;
    void* params[] = {&a};
    hipError_t e = hipLaunchCooperativeKernel((const void*)mega_fwd, dim3(grid), dim3(NT), params, LDS_BYTES, stream);
    if (e != hipSuccess) fprintf(stderr, "cooperative launch failed: %s (grid %d)\n", hipGetErrorString(e), grid);
}
```

```cpp
#include <hip/hip_runtime.h>
#include <hip/hip_cooperative_groups.h>
#include <cstdio>
#include <cstdint>
namespace cg = cooperative_groups;
namespace pg8 {
#define PG8_LAS __attribute__((address_space(3)))
typedef unsigned short bf16_t;
typedef short bf16x8 __attribute__((ext_vector_type(8)));
typedef float f32x4 __attribute__((ext_vector_type(4)));
typedef unsigned u32x4 __attribute__((ext_vector_type(4)));
constexpr int BM = 256, BK = 64, HALF = 128, HTB = HALF * BK * 2  , STAGE_BYTES = 8 * HTB, NXCD = 8, WGM = 8;

__host__ __device__ __forceinline__ int lds_byte(int r, int c) { const int st = (r >> 4) * 2 + (c >> 5), rr = r & 15, cc = c & 31, ob = rr * 64 + cc * 2; return st * 1024 + (ob ^ (((ob >> 9) & 1) << 5)); }
__host__ __device__ __forceinline__ void stage_rc(int b, int& R, int& C) { const int st = b / 1024, sb = b % 1024, swz = sb ^ (((sb >> 9) & 1) << 5); R = (st >> 1) * 16 + swz / 64; C = (st & 1) * 32 + (swz % 64) / 2; }
__host__ __device__ __forceinline__ int perm32(int rho) { const int n = rho >> 4, i = rho & 15; return 8 * (i >> 2) + 4 * n + (i & 3); }

struct Unit { int pm, pn; };
struct Gemm { const bf16_t* A; const bf16_t* Bt; int M, N, K, lda; };

struct StaticOrder {
    int nM, nN, nwg, G, c;
    __host__ __device__ void init(int M, int N, int G_, int c_) { nM = M / BM; nN = N / BM; nwg = nM * nN; G = G_; c = c_; }
    __host__ __device__ bool next(int i, Unit& u) const {
        const long L = (long)i * G + c; if (L >= nwg) return false;
        int wgid = (int)L; { const int q = nwg / NXCD, r = nwg % NXCD, xcd = wgid % NXCD, off = wgid / NXCD; wgid = (xcd < r ? xcd * (q + 1) : r * (q + 1) + (xcd - r) * q) + off; }
        const int nig = WGM * nN, gid = wgid / nig, fm = gid * WGM, gsz = (nM - fm) < WGM ? (nM - fm) : WGM;
        u.pm = fm + ((wgid % nig) % gsz); u.pn = (wgid % nig) / gsz; return true;
    }
    __device__ __forceinline__ void a_ready(const Unit&) const {}
    __device__ __forceinline__ void done(const Unit&) const {}
};

__device__ __forceinline__ unsigned cvt_pk_bf16(float lo, float hi) { unsigned r; asm volatile("v_cvt_pk_bf16_f32 %0, %1, %2" : "=v"(r) : "v"(lo), "v"(hi)); return r; }
typedef float f32x2 __attribute__((ext_vector_type(2)));
__device__ __forceinline__ float fast_sigmoid(float x) { return __builtin_amdgcn_rcpf(1.0f + __expf(-x)); }
__device__ __forceinline__ float gelu_tanh(float x) { const float z = 1.5957691216f * (x + 0.044715f * x * x * x); return x * fast_sigmoid(z); }
__device__ __forceinline__ float bf_lo(unsigned w) { return __uint_as_float(w << 16); }
__device__ __forceinline__ float bf_hi(unsigned w) { return __uint_as_float(w & 0xffff0000u); }

template <int MODE> struct EpiAct {
    static constexpr bool PERM = true, AFTER_DRAIN = false;
    bf16_t* O; int ldc;
    __device__ __forceinline__ void operator()(const f32x4 (&acc)[2][2][4][2], const Unit& u, int wr, int wc, int fr, int fq) const {
        const int row0 = u.pm * BM + wr * 64 + fr; const int col0 = u.pn * BM + wc * 32 + 8 * fq;
#pragma unroll
        for (int ai = 0; ai < 2; ++ai)
#pragma unroll
            for (int m = 0; m < 4; ++m) { bf16_t* rowp = O + (size_t)(row0 + ai * HALF + m * 16) * ldc + col0;
#pragma unroll
                for (int bj = 0; bj < 2; ++bj) { f32x4 v0 = acc[ai][bj][m][0], v1 = acc[ai][bj][m][1];
                    if (MODE == 1) {
#pragma unroll
                        for (int e = 0; e < 4; ++e) { v0[e] = gelu_tanh(v0[e]); v1[e] = gelu_tanh(v1[e]); } }
                    if (MODE == 2) {
#pragma unroll
                        for (int e = 0; e < 4; ++e) { float a = fmaxf(v0[e], 0.f), b = fmaxf(v1[e], 0.f); v0[e] = a * a; v1[e] = b * b; } }
                    u32x4 w; w.x = cvt_pk_bf16(v0[0], v0[1]); w.y = cvt_pk_bf16(v0[2], v0[3]); w.z = cvt_pk_bf16(v1[0], v1[1]); w.w = cvt_pk_bf16(v1[2], v1[3]);
                    *(u32x4*)(rowp + bj * HALF) = w; } }
    }
};
struct EpiGate {
    static constexpr bool PERM = true, AFTER_DRAIN = false;
    const bf16_t* T; bf16_t* MG; int ldc; int first;
    __device__ __forceinline__ void operator()(const f32x4 (&acc)[2][2][4][2], const Unit& u, int wr, int wc, int fr, int fq) const {
        const int row0 = u.pm * BM + wr * 64 + fr; const int col0 = u.pn * BM + wc * 32 + 8 * fq;
#pragma unroll
        for (int ai = 0; ai < 2; ++ai)
#pragma unroll
            for (int m = 0; m < 4; ++m) { const size_t off = (size_t)(row0 + ai * HALF + m * 16) * ldc + col0;
#pragma unroll
                for (int bj = 0; bj < 2; ++bj) { const f32x4 v0 = acc[ai][bj][m][0], v1 = acc[ai][bj][m][1];
                    const u32x4 t = *(const u32x4*)(T + off + bj * HALF);
                    u32x4 g = (u32x4){0u, 0u, 0u, 0u}; if (!first) g = *(const u32x4*)(MG + off + bj * HALF);
                    float o[8];
                    o[0] = bf_lo(g.x) + fast_sigmoid(v0[0]) * bf_lo(t.x); o[1] = bf_hi(g.x) + fast_sigmoid(v0[1]) * bf_hi(t.x);
                    o[2] = bf_lo(g.y) + fast_sigmoid(v0[2]) * bf_lo(t.y); o[3] = bf_hi(g.y) + fast_sigmoid(v0[3]) * bf_hi(t.y);
                    o[4] = bf_lo(g.z) + fast_sigmoid(v1[0]) * bf_lo(t.z); o[5] = bf_hi(g.z) + fast_sigmoid(v1[1]) * bf_hi(t.z);
                    o[6] = bf_lo(g.w) + fast_sigmoid(v1[2]) * bf_lo(t.w); o[7] = bf_hi(g.w) + fast_sigmoid(v1[3]) * bf_hi(t.w);
                    u32x4 w; w.x = cvt_pk_bf16(o[0], o[1]); w.y = cvt_pk_bf16(o[2], o[3]); w.z = cvt_pk_bf16(o[4], o[5]); w.w = cvt_pk_bf16(o[6], o[7]);
                    *(u32x4*)(MG + off + bj * HALF) = w; } }
    }
};
struct EpiResid {
    static constexpr bool PERM = false, AFTER_DRAIN = false;
    float* X; int ldc;
    __device__ __forceinline__ void operator()(const f32x4 (&acc)[2][2][4][2], const Unit& u, int wr, int wc, int fr, int fq) const {
        const int row0 = u.pm * BM + wr * 64 + fr; const int col0 = u.pn * BM + wc * 32 + 4 * fq;
#pragma unroll
        for (int ai = 0; ai < 2; ++ai)
#pragma unroll
            for (int m = 0; m < 4; ++m) { float* rowp = X + (size_t)(row0 + ai * HALF + m * 16) * ldc + col0;
#pragma unroll
                for (int bj = 0; bj < 2; ++bj)
#pragma unroll
                    for (int n = 0; n < 2; ++n) { f32x4* p = (f32x4*)(rowp + bj * HALF + n * 16); const f32x4 x = *p; *p = x + acc[ai][bj][m][n]; } }
    }
};
struct EpiMemKV {
    static constexpr bool PERM = false, AFTER_DRAIN = false;
    float* mk; float* mv;
    __device__ __forceinline__ void operator()(const f32x4 (&acc)[2][2][4][2], const Unit& u, int wr, int wc, int fr, int fq) const {
        const int l = u.pm >> 3; const int row0 = (u.pm & 7) * BM + wr * 64 + fr; int colt = (u.pn & 7) * BM;
        float* base = mk + (colt < 1024 ? (size_t)0 : (size_t)(mv - mk)) + (size_t)l * 2048 * 1024; colt &= 1023;
        const int col0 = colt + wc * 32 + 4 * fq;
#pragma unroll
        for (int ai = 0; ai < 2; ++ai)
#pragma unroll
            for (int m = 0; m < 4; ++m) { float* rowp = base + (size_t)(row0 + ai * HALF + m * 16) * 1024 + col0;
#pragma unroll
                for (int bj = 0; bj < 2; ++bj)
#pragma unroll
                    for (int n = 0; n < 2; ++n) *(f32x4*)(rowp + bj * HALF + n * 16) = acc[ai][bj][m][n]; }
    }
};
struct MemKVOrder {
    int G, c;
    __host__ __device__ bool next(int i, Unit& u) const { const int L = i * G + c; if (L >= 256) return false; const int l = L >> 6, r = L & 63; u.pm = l * 8 + (r >> 3); u.pn = l * 8 + (r & 7); return true; }
    __device__ __forceinline__ void a_ready(const Unit&) const {}
    __device__ __forceinline__ void done(const Unit&) const {}
};
struct EpiU {
    static constexpr bool AFTER_DRAIN = false;
    int mode; bool perm; bf16_t* O; const bf16_t* T; float* F; float* F2; int ldc; int first;
    __device__ __forceinline__ void operator()(const f32x4 (&acc)[2][2][4][2], const Unit& u, int wr, int wc, int fr, int fq) const {
        if (mode == 0) { EpiAct<0> e{O, ldc}; e(acc, u, wr, wc, fr, fq); }
        else if (mode == 1) { EpiAct<1> e{O, ldc}; e(acc, u, wr, wc, fr, fq); }
        else if (mode == 2) { EpiAct<2> e{O, ldc}; e(acc, u, wr, wc, fr, fq); }
        else if (mode == 3) { EpiGate e{T, O, ldc, first}; e(acc, u, wr, wc, fr, fq); }
        else if (mode == 4) { EpiResid e{F, ldc}; e(acc, u, wr, wc, fr, fq); }
        else { EpiMemKV e{F, F2}; e(acc, u, wr, wc, fr, fq); }
    }
};
struct OrderU {
    StaticOrder so; int memkv; int half;
    __device__ bool next(int i, Unit& u) const {
        if (half) { if (!so.next(i, u)) return false; const int tpb = half == 2 ? 23 : 9; const int bq = u.pm / tpb; u.pm = bq * 32 + (u.pm - bq * tpb) + (half == 2 ? 9 : 0); return true; }
        if (memkv) { const int L = i * so.G + so.c; if (L >= 256) return false; const int l = L >> 6, r = L & 63; u.pm = l * 8 + (r >> 3); u.pn = l * 8 + (r & 7); return true; }
        return so.next(i, u);
    }
    __device__ __forceinline__ void a_ready(const Unit&) const {}
    __device__ __forceinline__ void done(const Unit&) const {}
};
template <class Epi, class Sched, bool ALIGN_EPI = false, bool SP2 = false>
__device__ __forceinline__ void gemm_phase(PG8_LAS unsigned char* lds, const Gemm g, const Sched& S, const Epi& E) {
    int tid_ = threadIdx.x; asm volatile("" : "+v"(tid_)); const int tid = tid_, wid = __builtin_amdgcn_readfirstlane(tid >> 6), lane = tid & 63, wr = wid >> 2, wc = wid & 3, fr = lane & 15, fq = lane >> 4;
    const int K = g.K, nt = K / BK;
    unsigned voffA[2], voffB[2];
#pragma unroll
    for (int i = 0; i < 2; ++i) { int R, C; stage_rc(tid * 16 + i * 8192, R, C); const int Rb = E.perm ? ((R & ~31) + perm32(R & 31)) : R;
        voffA[i] = (unsigned)(R * g.lda + C) * 2u; voffB[i] = (unsigned)(Rb * K + C) * 2u; }
    const size_t kstep = (size_t)(BK * 2);
    const size_t hstep = (size_t)HALF * K * 2;
    const size_t tstep = 2 * hstep;
    const size_t hstepA = (size_t)HALF * g.lda * 2, tstepA = 2 * hstepA;
    const unsigned ldsw = (unsigned)wid * 1024u;
    const int aoff = lds_byte(wr * 64 + fr, fq * 8), boff = lds_byte(wc * 32 + fr, fq * 8);
#define PG8_SA(b, h) (((b) * 2 + (h)) * HTB)
#define PG8_SB(b, h) ((4 + (b) * 2 + (h)) * HTB)
#define PG8_STAGE(bufoff, gbase, voff) do { _Pragma("unroll") for (int _i = 0; _i < 2; ++_i) \
        __builtin_amdgcn_global_load_lds((const unsigned*)((const char*)(gbase) + (voff)[_i]), (PG8_LAS unsigned*)(lds + (bufoff) + ldsw + _i * 8192), 16, 0, 0); } while (0)
#define PG8_LDA(dst, b, h) do { _Pragma("unroll") for (int m = 0; m < 4; ++m) _Pragma("unroll") for (int k = 0; k < 2; ++k) dst[m][k] = *(const PG8_LAS bf16x8*)(lds + PG8_SA(b, h) + aoff + m * 2048 + k * 1024); } while (0)
#define PG8_LDB(dst, b, h) do { _Pragma("unroll") for (int n = 0; n < 2; ++n) _Pragma("unroll") for (int k = 0; k < 2; ++k) dst[n][k] = *(const PG8_LAS bf16x8*)(lds + PG8_SB(b, h) + boff + n * 2048 + k * 1024); } while (0)
#define PG8_MMA(ai, bj, At, Bt) do { __builtin_amdgcn_s_setprio(1); _Pragma("unroll") for (int m = 0; m < 4; ++m) _Pragma("unroll") for (int n = 0; n < 2; ++n) _Pragma("unroll") for (int k = 0; k < 2; ++k) \
        acc[ai][bj][m][n] = __builtin_amdgcn_mfma_f32_16x16x32_bf16(Bt[n][k], At[m][k], acc[ai][bj][m][n], 0, 0, 0); __builtin_amdgcn_s_setprio(0); } while (0)
#define PG8_WAIT_V(n) asm volatile("s_waitcnt vmcnt(" #n ")" ::: "memory")
#define PG8_WAIT_L(n) asm volatile("s_waitcnt lgkmcnt(" #n ")" ::: "memory")
#define PG8_BAR __builtin_amdgcn_s_barrier()
#define PG8_SCHED __builtin_amdgcn_sched_barrier(0)
    Unit cur, nxt; int ui = 0;
    if (!S.next(0, cur)) return;
    f32x4 acc[2][2][4][2];
#pragma unroll
    for (int a = 0; a < 2; ++a)
#pragma unroll
        for (int b = 0; b < 2; ++b)
#pragma unroll
            for (int m = 0; m < 4; ++m)
#pragma unroll
                for (int n = 0; n < 2; ++n) acc[a][b][m][n] = (f32x4){0.f, 0.f, 0.f, 0.f};
    bf16x8 At[4][2], B0[2][2], B1[2][2];
    const char* cA = (const char*)g.A + (size_t)cur.pm * tstepA; const char* cB = (const char*)g.Bt + (size_t)cur.pn * tstep;
    S.a_ready(cur);
    if constexpr (SP2) {
        PG8_STAGE(PG8_SB(0, 0), cB, voffB); PG8_STAGE(PG8_SB(0, 1), cB + hstep, voffB); PG8_STAGE(PG8_SA(0, 0), cA, voffA); PG8_STAGE(PG8_SA(0, 1), cA + hstepA, voffA);
        if (wr == 1) PG8_BAR;
        PG8_WAIT_V(2); PG8_BAR;
        PG8_STAGE(PG8_SB(1, 0), cB + kstep, voffB); PG8_STAGE(PG8_SA(1, 0), cA + kstep, voffA); PG8_STAGE(PG8_SB(1, 1), cB + hstep + kstep, voffB);
        PG8_WAIT_V(6); PG8_BAR;
    } else {
        PG8_STAGE(PG8_SB(0, 0), cB, voffB); PG8_STAGE(PG8_SA(0, 0), cA, voffA); PG8_STAGE(PG8_SB(0, 1), cB + hstep, voffB); PG8_STAGE(PG8_SA(0, 1), cA + hstepA, voffA);
        if (wr == 1) PG8_BAR;
        PG8_WAIT_V(4); PG8_BAR;
        PG8_STAGE(PG8_SB(1, 0), cB + kstep, voffB); PG8_STAGE(PG8_SA(1, 0), cA + kstep, voffA); PG8_STAGE(PG8_SB(1, 1), cB + hstep + kstep, voffB);
        PG8_WAIT_V(6); PG8_BAR;
    }
    for (;;) {
        const bool has_next = S.next(ui + 1, nxt);
        const char* nA = has_next ? (const char*)g.A + (size_t)nxt.pm * tstepA : cA; const char* nB = has_next ? (const char*)g.Bt + (size_t)nxt.pn * tstep : cB;
        for (int t = 0; t < nt; t += 2) {
            const bool last = (t == nt - 2);
            const char* a1 = cA + (size_t)(t + 1) * kstep;
            const char* a2 = last ? nA : cA + (size_t)(t + 2) * kstep; const char* b2 = last ? nB : cB + (size_t)(t + 2) * kstep;
            const char* a3 = a2 + kstep; const char* b3 = b2 + kstep;
            if (last && has_next) S.a_ready(nxt);
            if constexpr (SP2) {
            PG8_LDB(B0, 0, 0); PG8_LDB(B1, 0, 1); PG8_SCHED; PG8_LDA(At, 0, 0); PG8_STAGE(PG8_SA(1, 1), a1 + hstepA, voffA);
            PG8_WAIT_V(8); PG8_WAIT_L(0); PG8_BAR; PG8_MMA(0, 0, At, B0); PG8_MMA(0, 1, At, B1); PG8_BAR; PG8_SCHED;
            PG8_LDA(At, 0, 1); PG8_STAGE(PG8_SB(0, 0), b2, voffB); PG8_STAGE(PG8_SB(0, 1), b2 + hstep, voffB); PG8_STAGE(PG8_SA(0, 0), a2, voffA);
            PG8_WAIT_V(8); PG8_WAIT_L(0); PG8_BAR; PG8_MMA(1, 0, At, B0); PG8_MMA(1, 1, At, B1); PG8_BAR; PG8_SCHED;
            PG8_LDB(B0, 1, 0); PG8_LDB(B1, 1, 1); PG8_SCHED; PG8_LDA(At, 1, 0); PG8_STAGE(PG8_SA(0, 1), a2 + hstepA, voffA);
            PG8_WAIT_V(8); PG8_WAIT_L(0); PG8_BAR; PG8_MMA(0, 0, At, B0); PG8_MMA(0, 1, At, B1); PG8_BAR; PG8_SCHED;
            PG8_LDA(At, 1, 1); PG8_STAGE(PG8_SB(1, 0), b3, voffB); PG8_STAGE(PG8_SB(1, 1), b3 + hstep, voffB); PG8_STAGE(PG8_SA(1, 0), a3, voffA);
            PG8_WAIT_V(8); PG8_WAIT_L(0); PG8_BAR; PG8_MMA(1, 0, At, B0); PG8_MMA(1, 1, At, B1); PG8_BAR; PG8_SCHED;
            } else {
            PG8_LDB(B0, 0, 0); PG8_SCHED; PG8_LDA(At, 0, 0); PG8_STAGE(PG8_SA(1, 1), a1 + hstepA, voffA);
            PG8_WAIT_L(8); PG8_BAR; PG8_WAIT_L(0); PG8_MMA(0, 0, At, B0); PG8_BAR; PG8_SCHED;
            PG8_LDB(B1, 0, 1); PG8_STAGE(PG8_SB(0, 0), b2, voffB);
            PG8_BAR; PG8_WAIT_L(0); PG8_MMA(0, 1, At, B1); PG8_BAR;
            PG8_LDA(At, 0, 1); PG8_STAGE(PG8_SA(0, 0), a2, voffA);
            PG8_BAR; PG8_WAIT_L(0); PG8_MMA(1, 0, At, B0); PG8_BAR; PG8_SCHED;
            PG8_STAGE(PG8_SB(0, 1), b2 + hstep, voffB);
            PG8_WAIT_V(6); PG8_BAR; PG8_MMA(1, 1, At, B1); PG8_BAR;
            PG8_LDB(B0, 1, 0); PG8_SCHED; PG8_LDA(At, 1, 0); PG8_STAGE(PG8_SA(0, 1), a2 + hstepA, voffA);
            PG8_WAIT_L(8); PG8_BAR; PG8_WAIT_L(0); PG8_MMA(0, 0, At, B0); PG8_BAR; PG8_SCHED;
            PG8_LDB(B1, 1, 1); PG8_STAGE(PG8_SB(1, 0), b3, voffB);
            PG8_BAR; PG8_WAIT_L(0); PG8_MMA(0, 1, At, B1); PG8_BAR;
            PG8_LDA(At, 1, 1); PG8_STAGE(PG8_SA(1, 0), a3, voffA);
            PG8_BAR; PG8_WAIT_L(0); PG8_MMA(1, 0, At, B0); PG8_BAR; PG8_SCHED;
            PG8_STAGE(PG8_SB(1, 1), b3 + hstep, voffB);
            PG8_WAIT_V(6); PG8_BAR; PG8_MMA(1, 1, At, B1); PG8_BAR;
            }
        }
        if constexpr (ALIGN_EPI) { if (wr == 0) PG8_BAR; }
        if constexpr (!Epi::AFTER_DRAIN) { E(acc, cur, wr, wc, fr, fq); S.done(cur); }
        if (!has_next) break;
#pragma unroll
        for (int a = 0; a < 2; ++a)
#pragma unroll
            for (int b = 0; b < 2; ++b)
#pragma unroll
                for (int m = 0; m < 4; ++m)
#pragma unroll
                    for (int n = 0; n < 2; ++n) acc[a][b][m][n] = (f32x4){0.f, 0.f, 0.f, 0.f};
        cur = nxt; cA = nA; cB = nB; ++ui;
        if constexpr (ALIGN_EPI) { if (wr == 1) PG8_BAR; }
    }
    PG8_WAIT_V(0);
    if constexpr (!ALIGN_EPI) { if (wr == 0) PG8_BAR; }
    PG8_BAR;
    if constexpr (Epi::AFTER_DRAIN) { E.fused(acc, cur, wr, wc, fr, fq, lds, wid, lane); S.done(cur); }
#undef PG8_SA
#undef PG8_SB
#undef PG8_STAGE
#undef PG8_LDA
#undef PG8_LDB
#undef PG8_MMA
#undef PG8_WAIT_V
#undef PG8_WAIT_L
#undef PG8_BAR
#undef PG8_SCHED
}
}
#define LAS __attribute__((address_space(3)))
typedef unsigned short bf16;
typedef unsigned v4u __attribute__((ext_vector_type(4)));
typedef unsigned v2u __attribute__((ext_vector_type(2)));
typedef float f32x4 __attribute__((ext_vector_type(4)));
typedef float f32x2 __attribute__((ext_vector_type(2)));
typedef short bf16x8 __attribute__((ext_vector_type(8)));
constexpr int NT = 512, NWAVES = 8;
constexpr int DM = 1024, NB = 8, SEQ = 8192, DEPTH = 4, DECS = 32;
constexpr int MP = NB * SEQ, MS = NB * DECS, M = MP + MS;
constexpr int RC = 3328, INC = 9472, COL_GMLP = 3328, COL_Q = 5376, COL_GATE = 6400, DFF = 4096;
constexpr int NMEM = 256;
constexpr size_t O_Y = 0, O_MK = (size_t)M * DM, O_MV = O_MK + (size_t)DEPTH * NB * NMEM * DM, O_WKVP = O_MV + (size_t)DEPTH * NB * NMEM * DM,
    O_SHP = O_WKVP + (size_t)DEPTH * NB * 16 * 64 * 64, O_WKVS = O_SHP + (size_t)DEPTH * NB * RC, O_SHS = O_WKVS + (size_t)DEPTH * NB * 16 * 64 * 64,
    O_SGUV = O_SHS + (size_t)DEPTH * NB * RC, O_END = O_SGUV + (size_t)DEPTH * NB * DECS * DM;
constexpr size_t A1 = (size_t)M * DM * 2;
constexpr size_t WS_WIN = 1u << 20;
constexpr size_t WS_WB = WS_WIN + (size_t)INC * DM * 2;
constexpr size_t WS_WOUT = WS_WB + 3ull * DM * DM * 2;
constexpr size_t WS_WUP = WS_WOUT + (size_t)DM * DM * 2;
constexpr size_t WS_WDN = WS_WUP + (size_t)DFF * DM * 2;
constexpr size_t WS_W2T = WS_WDN + (size_t)DFF * DM * 2;
constexpr size_t WS_A2T = WS_W2T + 1024 * 64 * 2;
constexpr size_t WS_G2T = WS_A2T + 1024 * 64 * 2;
constexpr size_t WS_WS = WS_G2T + 1024 * 128 * 2;
constexpr size_t WS_KB = WS_WS + 8 * 128 * 128 * 2;
constexpr size_t WS_VT = WS_KB + 16ull * 256 * 1024 * 2;
constexpr size_t WS_H = WS_VT + 16ull * 256 * 1024 * 2;
constexpr size_t WS_Y = WS_H + A1, WS_T = WS_Y + A1, WS_MG = WS_T + A1, WS_BIG = WS_MG + A1;
constexpr size_t WS_END = WS_BIG + (size_t)M * RC * 2;
constexpr size_t WS_UVB = WS_T;
constexpr size_t WS_T2 = WS_BIG, WS_MG2 = WS_BIG + A1;
constexpr size_t WS_UP = WS_Y;
static_assert(WS_UP + (size_t)M * DFF * 2 <= WS_END, "up overlay");
constexpr size_t WS_AMEM = WS_BIG;
constexpr size_t WS_WMKV = WS_BIG + 4ull * 2048 * 1024 * 2;
static_assert(WS_END <= (1024ull << 20), "workspace");
constexpr int LDS_BYTES = 147456;

struct Args { const float* in[32]; float* out; unsigned char* ws; };

__device__ __forceinline__ unsigned f2bf(float f) { unsigned u = __builtin_bit_cast(unsigned, f); return (u + 0x7fffu + ((u >> 16) & 1u)) >> 16; }
__device__ __forceinline__ unsigned pk2(float lo, float hi) { return pg8::cvt_pk_bf16(lo, hi); }
typedef __bf16 bf16x2_t __attribute__((ext_vector_type(2)));
__device__ __forceinline__ unsigned pk2c(float lo, float hi) { const f32x2 v = {lo, hi}; const bf16x2_t b = __builtin_convertvector(v, bf16x2_t); return __builtin_bit_cast(unsigned, b); }
__device__ __forceinline__ float bflo(unsigned w) { return __uint_as_float(w << 16); }
__device__ __forceinline__ float bfhi(unsigned w) { return __uint_as_float(w & 0xffff0000u); }
__device__ __forceinline__ void unpack8(const v4u w, float* o) { o[0] = bflo(w.x); o[1] = bfhi(w.x); o[2] = bflo(w.y); o[3] = bfhi(w.y); o[4] = bflo(w.z); o[5] = bfhi(w.z); o[6] = bflo(w.w); o[7] = bfhi(w.w); }
__device__ __forceinline__ v4u pack8(const float* o) { v4u w; w.x = pk2(o[0], o[1]); w.y = pk2(o[2], o[3]); w.z = pk2(o[4], o[5]); w.w = pk2(o[6], o[7]); return w; }
__device__ __forceinline__ float wave_sum(float v) {
#pragma unroll
    for (int o = 1; o < 64; o <<= 1) v += __shfl_xor(v, o);
    return v;
}
template <int CTRL> __device__ __forceinline__ float dppf(float x) { return __builtin_bit_cast(float, __builtin_amdgcn_mov_dpp(__builtin_bit_cast(int, x), CTRL, 0xf, 0xf, true)); }
__device__ __forceinline__ float row16_sum(float v) { v += dppf<0xB1>(v); v += dppf<0x4E>(v); v += dppf<0x141>(v); v += dppf<0x128>(v); return v; }
#define LDS_WAIT() asm volatile("s_waitcnt lgkmcnt(0)" ::: "memory")
__device__ __forceinline__ void sub_barrier(unsigned* cnt, unsigned target) {
    asm volatile("s_waitcnt vmcnt(0)" ::: "memory");
    __syncthreads();
    if (threadIdx.x == 0) {
        __builtin_amdgcn_fence(__ATOMIC_RELEASE, "agent");
        asm volatile("s_waitcnt vmcnt(0)" ::: "memory");
        __hip_atomic_fetch_add(cnt, 1u, __ATOMIC_RELAXED, __HIP_MEMORY_SCOPE_AGENT);
        while (__hip_atomic_load(cnt, __ATOMIC_RELAXED, __HIP_MEMORY_SCOPE_AGENT) < target) __builtin_amdgcn_s_sleep(2);
        __builtin_amdgcn_fence(__ATOMIC_ACQUIRE, "agent");
        asm volatile("s_waitcnt vmcnt(0)" ::: "memory");
    }
    __syncthreads();
}

__device__ __forceinline__ void transpose_item(const float* W, int ldw, int N, bf16* WT, int ldt, LAS float* scr, int item, int lane, bool vperm) {
    const int nblk = N / 32, kb = item / nblk, nb = item % nblk, k0 = 64 * kb, n0 = 32 * nb;
#pragma unroll 8
    for (int i = 0; i < 32; ++i) { const int kk = 2 * i + (lane >> 5); scr[kk * 33 + (lane & 31)] = W[(size_t)(k0 + kk) * ldw + n0 + (lane & 31)]; }
    LDS_WAIT();
    const int c = lane & 7;
    const int rlo = vperm ? ((c >> 2) * 32 + 4 * (c & 3)) : 8 * c, rhi = vperm ? rlo + 16 : rlo + 4;
#pragma unroll
    for (int j = 0; j < 4; ++j) { const int n = (lane >> 3) + 8 * j; const LAS float* s = scr + rlo * 33 + n; const LAS float* s2 = scr + rhi * 33 + n;
        v4u o; o.x = pk2(s[0 * 33], s[1 * 33]); o.y = pk2(s[2 * 33], s[3 * 33]); o.z = pk2(s2[0 * 33], s2[1 * 33]); o.w = pk2(s2[2 * 33], s2[3 * 33]);
        *(v4u*)(WT + (size_t)(n0 + n) * ldt + k0 + 8 * c) = o; }
    LDS_WAIT();
}
__device__ __forceinline__ void rms_row_bf16(const float* xrow, const float* g, bf16* orow, int lane) {
    const f32x4* xr = (const f32x4*)xrow + lane; const f32x4* gr = (const f32x4*)g + lane;
    f32x4 v[4]; float s = 0.f;
#pragma unroll
    for (int j = 0; j < 4; ++j) { v[j] = xr[64 * j]; s += (v[j].x * v[j].x + v[j].y * v[j].y) + (v[j].z * v[j].z + v[j].w * v[j].w); }
    const float r = 1.0f / sqrtf(wave_sum(s) * (1.f / DM) + 1e-6f);
    v2u* o8 = (v2u*)orow + lane;
#pragma unroll
    for (int j = 0; j < 4; ++j) { const f32x4 gg = gr[64 * j]; v2u w; w.x = pk2(v[j].x * r * gg.x, v[j].y * r * gg.y); w.y = pk2(v[j].z * r * gg.z, v[j].w * r * gg.w); o8[64 * j] = w; }
}

struct Ctx {
    const float* const* in; float* out; unsigned char* ws; LAS unsigned char* lds;
    int tid, lane, wave, gw, ngw;
};

__device__ __forceinline__ void prep_phase(const Ctx& C, int kind, int l2) {
    LAS float* scr = (LAS float*)(C.lds + C.wave * 16384);
    constexpr int I_IN = 16 * (INC / 32), I_SQ = 16 * 32, I_UP = 16 * (DFF / 32), I_DN = 64 * 32, I_L64 = 32, I_L128 = 64, I_VT = 16 * 4 * 32;
    constexpr int NIT = I_IN + 4 * I_SQ + I_UP + I_DN + 2 * I_L64 + I_L128 + I_VT;
    constexpr int ITM = (1024 / 64) * (2048 / 32);
    const int l = kind >= 0 ? kind : 0;
    const int nit = kind >= 0 ? NIT : kind == -1 ? 4 * ITM : 0;
    for (int it = C.gw; it < nit; it += C.ngw) {
        int r = it; const float* src; int ldw, N, ldt; size_t dst; bool vperm = false;
        if (kind < 0) { const int ll = it / ITM; r = it % ITM; src = C.in[12] + (size_t)ll * 1024 * 2048; ldw = 2048; N = 2048; dst = WS_WMKV + (size_t)ll * 2048 * 1024 * 2; ldt = 1024; }
        else if (r < I_IN) { src = C.in[11] + (size_t)l * DM * INC; ldw = INC; N = INC; dst = WS_WIN; ldt = DM; }
        else if ((r -= I_IN) < 3 * I_SQ) { const int b = r / I_SQ; r = r % I_SQ; src = C.in[28] + ((size_t)l * 3 + b) * DM * DM; ldw = DM; N = DM; dst = WS_WB + (size_t)b * DM * DM * 2; ldt = DM; }
        else if ((r -= 3 * I_SQ) < I_SQ) { src = C.in[29] + (size_t)l * DM * DM; ldw = DM; N = DM; dst = WS_WOUT; ldt = DM; }
        else if ((r -= I_SQ) < I_UP) { src = C.in[30] + (size_t)l * DM * DFF; ldw = DFF; N = DFF; dst = WS_WUP; ldt = DM; }
        else if ((r -= I_UP) < I_DN) { src = C.in[31] + (size_t)l * DFF * DM; ldw = DM; N = DM; dst = WS_WDN; ldt = DFF; }
        else if ((r -= I_DN) < I_L64) { src = C.in[15] + (size_t)l * 64 * DM; ldw = DM; N = DM; dst = WS_W2T; ldt = 64; }
        else if ((r -= I_L64) < I_L64) { src = C.in[17] + (size_t)l * 64 * DM; ldw = DM; N = DM; dst = WS_A2T; ldt = 64; }
        else if ((r -= I_L64) < I_L128) { src = C.in[18] + (size_t)l * 128 * DM; ldw = DM; N = DM; dst = WS_G2T; ldt = 128; }
        else { r -= I_L128; const int bbh = r >> 5, bb = bbh >> 2, h = bbh & 3; r &= 31;
            src = (bb < 8 ? C.out + O_MV + ((size_t)l * 8 + bb) * 256 * 1024 : C.in[3] + ((size_t)l * 8 + (bb - 8)) * 256 * 1024) + h * 256;
            ldw = 1024; N = 256; dst = WS_VT + (size_t)bbh * 65536 * 2; ldt = 256; vperm = true; }
        transpose_item(src, ldw, N, (bf16*)(C.ws + dst), ldt, scr, r, C.lane, vperm);
    }
    if (kind == -1) {
        float* X = C.out;
        const f32x4* s = (const f32x4*)C.in[0]; f32x4* d = (f32x4*)X; const size_t n = (size_t)MP * DM / 4;
        for (size_t i = (size_t)blockIdx.x * NT + C.tid; i < n; i += (size_t)gridDim.x * NT) d[i] = s[i];
        const f32x4* s2 = (const f32x4*)C.in[1]; f32x4* d2 = (f32x4*)(X + (size_t)MP * DM); const size_t n2 = (size_t)MS * DM / 4;
        for (size_t i = (size_t)blockIdx.x * NT + C.tid; i < n2; i += (size_t)gridDim.x * NT) d2[i] = s2[i];
    }
    if (kind >= 0) {
        { v4u* d = (v4u*)(C.ws + WS_KB); const size_t n = 16ull * 256 * 1024 / 8;
          for (size_t i = (size_t)blockIdx.x * NT + C.tid; i < n; i += (size_t)gridDim.x * NT) { const size_t e = i * 8; const int bb = (int)(e >> 18); const size_t o = e & 262143;
              const float* s = (bb < 8 ? C.out + O_MK + ((size_t)l * 8 + bb) * 262144 : C.in[2] + ((size_t)l * 8 + (bb - 8)) * 262144) + o;
              const f32x4 a = *(const f32x4*)s, b = *(const f32x4*)(s + 4); v4u w; w.x = pk2(a.x, a.y); w.y = pk2(a.z, a.w); w.z = pk2(b.x, b.y); w.w = pk2(b.z, b.w); d[i] = w; } }
        { bf16* d = (bf16*)(C.ws + WS_WS); const float* s = C.in[26] + (size_t)l * 8 * 128 * 128;
          for (int i = blockIdx.x * NT + C.tid; i < 8 * 128 * 128; i += gridDim.x * NT) { const int ii = (i >> 7) & 127, jj = i & 127; d[i] = (bf16)f2bf(jj <= ii ? s[i] : 0.f); } }
    }
    { const float* sb; const float* gb; size_t db; int nrows, smask, gshift;
      if (kind == -1) { sb = C.in[6]; gb = C.in[8]; db = WS_AMEM; nrows = 4 * 2048; smask = 2047; gshift = 11; }
      else { sb = C.out; gb = (kind >= 0 ? C.in[7] : C.in[9]) + (kind >= 0 ? l : l2) * DM; db = WS_H; nrows = M; smask = 0x7fffffff; gshift = 30; }
      for (int it = C.gw; it < nrows; it += 2 * C.ngw) { const int it2 = it + C.ngw;
          const f32x4* xa = (const f32x4*)(sb + (size_t)(it & smask) * DM) + C.lane; const bool has2 = it2 < nrows; const f32x4* xb = (const f32x4*)(sb + (size_t)((has2 ? it2 : it) & smask) * DM) + C.lane;
          f32x4 va[4], vb[4]; float sa = 0.f, sb2 = 0.f;
#pragma unroll
          for (int j = 0; j < 4; ++j) { va[j] = xa[64 * j]; vb[j] = xb[64 * j]; }
#pragma unroll
          for (int j = 0; j < 4; ++j) { sa += (va[j].x * va[j].x + va[j].y * va[j].y) + (va[j].z * va[j].z + va[j].w * va[j].w); sb2 += (vb[j].x * vb[j].x + vb[j].y * vb[j].y) + (vb[j].z * vb[j].z + vb[j].w * vb[j].w); }
          const float ra = 1.0f / sqrtf(wave_sum(sa) * (1.f / DM) + 1e-6f), rb = 1.0f / sqrtf(wave_sum(sb2) * (1.f / DM) + 1e-6f);
          const f32x4* ga = (const f32x4*)(gb + (size_t)(it >> gshift) * DM) + C.lane; const f32x4* gb2 = (const f32x4*)(gb + (size_t)((has2 ? it2 : it) >> gshift) * DM) + C.lane;
          v2u* oa = (v2u*)((bf16*)(C.ws + db) + (size_t)it * DM) + C.lane; v2u* ob = (v2u*)((bf16*)(C.ws + db) + (size_t)(has2 ? it2 : it) * DM) + C.lane;
#pragma unroll
          for (int j = 0; j < 4; ++j) { const f32x4 g1 = ga[64 * j], g2 = gb2[64 * j]; v2u w1, w2;
              w1.x = pk2(va[j].x * ra * g1.x, va[j].y * ra * g1.y); w1.y = pk2(va[j].z * ra * g1.z, va[j].w * ra * g1.w); oa[64 * j] = w1;
              w2.x = pk2(vb[j].x * rb * g2.x, vb[j].y * rb * g2.y); w2.y = pk2(vb[j].z * rb * g2.z, vb[j].w * rb * g2.w); if (has2) ob[64 * j] = w2; } } }
}

constexpr int RW_MAIN = 0, RW_MSTR = 20608, RW_POST = 41216, RW_YC = 66176, RW_XL = 74368, RW_ZR = 83072, RW_LW = 95360, RW_MU = 131200;
struct RawRegs { v4u cur[4]; v4u prv[4]; };
__device__ __forceinline__ float row8_sum(float v) { v += dppf<0xB1>(v); v += dppf<0x4E>(v); v += dppf<0x141>(v); return v; }
__device__ __forceinline__ void rw_issue(RawRegs& rr, const bf16* PRu, int T, int cn, int pw, const int (&ioff)[4], const int (&itl)[4]) {
    const bf16* pc = PRu + (size_t)cn * (16 * RC);
#pragma unroll
    for (int j = 0; j < 4; ++j) { const int t = cn * 16 + 4 * pw + itl[j];
        rr.cur[j] = (v4u){0u, 0u, 0u, 0u}; rr.prv[j] = (v4u){0u, 0u, 0u, 0u};
        if (ioff[j] >= 0 && t < T) { rr.cur[j] = *(const v4u*)(pc + ioff[j]); if (t > 0) rr.prv[j] = *(const v4u*)(pc + ioff[j] - RC); } }
}
template <int KIND> __device__ __forceinline__ void rw_a1_item(const v4u cw, const v4u pw_, int t, int t4, int q, int tok, const LAS float* MU, LAS float* Mb, LAS float* Pf, LAS bf16* XLw) {
    float cur[8], prv[8]; unpack8(cw, cur); unpack8(pw_, prv);
    if (t == 0) { const f32x4 x0 = *(const LAS f32x4*)(MU + 448 + q * 8), x1 = *(const LAS f32x4*)(MU + 452 + q * 8);
        prv[0] = x0.x; prv[1] = x0.y; prv[2] = x0.z; prv[3] = x0.w; prv[4] = x1.x; prv[5] = x1.y; prv[6] = x1.z; prv[7] = x1.w; }
    const f32x4 m0 = *(const LAS f32x4*)(MU + q * 8), m1 = *(const LAS f32x4*)(MU + q * 8 + 4);
    const float mm[8] = {m0.x, m0.y, m0.z, m0.w, m1.x, m1.y, m1.z, m1.w}; float mx[8];
#pragma unroll
    for (int e = 0; e < 8; ++e) mx[e] = cur[e] + (prv[e] - cur[e]) * mm[e];
    if (KIND == 0) { LAS float* dst = (q < 8 ? Mb : q < 16 ? Mb + 1024 : Pf + 1024) + tok * 64 + (q & 7) * 8;
        *(LAS f32x4*)dst = (f32x4){mx[0], mx[1], mx[2], mx[3]}; *(LAS f32x4*)(dst + 4) = (f32x4){mx[4], mx[5], mx[6], mx[7]}; }
    else { float o[8];
#pragma unroll
        for (int e = 0; e < 8; ++e) { if (KIND == 1) o[e] = mx[e]; else if (KIND == 2) { const float ex = __expf(2.0f * mx[e]); o[e] = 1.0f - 2.0f * __builtin_amdgcn_rcpf(ex + 1.0f); } else o[e] = pg8::fast_sigmoid(mx[e]); }
        *(LAS v4u*)(XLw + t4 * 264 + (q - 24) * 8) = pack8(o); }
}
__device__ __forceinline__ void rwkv_unit(const Ctx& C, int l, int sample, int b, int h) {
    LAS unsigned char* L = C.lds;
    const int T = sample ? DECS : SEQ, NC = T / 16; const size_t rowbase = sample ? (size_t)MP + (size_t)b * DECS : (size_t)b * SEQ;
    const bf16* PR = (const bf16*)(C.ws + WS_BIG); bf16* Yg = (bf16*)(C.ws + WS_Y);
    const int lane = C.lane, w = C.wave;
    __syncthreads();
    if (w < 4) {
        const int rowl = lane & 15, fq = lane >> 4, row = 16 * w + rowl;
        const unsigned m0 = fq == 0 ? 0xffffffffu : 0u;
        f32x4 S0 = (f32x4){0.f, 0.f, 0.f, 0.f}, S1 = S0, S2 = S0, S3 = S0;
        if (sample) { const float* sp = C.in[4] + ((((size_t)l * 8 + b) * 16 + h) * 64 + row) * 64 + 4 * fq;
            S0 = *(const f32x4*)sp; S1 = *(const f32x4*)(sp + 16); S2 = *(const f32x4*)(sp + 32); S3 = *(const f32x4*)(sp + 48); }
        const int asel = ((rowl & 3) == 0 ? 0 : 1024) + 4 * fq;
        __syncthreads();
        __syncthreads();
        for (int c = 0; c < NC; ++c) {
            const LAS float* Mb = (const LAS float*)(L + RW_MAIN + (c & 1) * RW_MSTR);
            const LAS float* Wp = Mb + 2048 + 4 * fq;
            const LAS unsigned* BKp = (const LAS unsigned*)(Mb + 4096) + rowl;
            const LAS bf16* Ap = (const LAS bf16*)(Mb + 3072) + asel;
            const LAS float* Vb = (const LAS float*)(L + RW_POST + (c % 3) * 8320 + 4096) + row;
            LAS float* Yb = (LAS float*)(L + RW_YC + (c & 1) * 4096) + row;
#define RW_LD(t_, W0, W1, W2, W3, K0, K1, K2, K3, A00, A01, A10, A11, VV, SC) do { const int o_ = (t_) * 64; \
                W0 = *(const LAS f32x4*)(Wp + o_); W1 = *(const LAS f32x4*)(Wp + o_ + 16); W2 = *(const LAS f32x4*)(Wp + o_ + 32); W3 = *(const LAS f32x4*)(Wp + o_ + 48); \
                K0 = BKp[o_]; K1 = BKp[o_ + 16]; K2 = BKp[o_ + 32]; K3 = BKp[o_ + 48]; \
                A00 = *(const LAS v2u*)(Ap + o_); A01 = *(const LAS v2u*)(Ap + o_ + 16); A10 = *(const LAS v2u*)(Ap + o_ + 32); A11 = *(const LAS v2u*)(Ap + o_ + 48); \
                VV = Vb[o_]; SC = *(const LAS f32x2*)(Mb + 5120 + (t_) * 2); } while (0)
            f32x4 w_0, w_1, w_2, w_3; unsigned k_0, k_1, k_2, k_3; v2u a00, a01, a10, a11; float vv; f32x2 sc;
            RW_LD(0, w_0, w_1, w_2, w_3, k_0, k_1, k_2, k_3, a00, a01, a10, a11, vv, sc);
#pragma unroll
            for (int t = 0; t < 16; ++t) {
                const int tn = t < 15 ? t + 1 : 15;
                f32x4 nw_0, nw_1, nw_2, nw_3; unsigned nk_0, nk_1, nk_2, nk_3; v2u na00, na01, na10, na11; float nvv; f32x2 nsc;
                RW_LD(tn, nw_0, nw_1, nw_2, nw_3, nk_0, nk_1, nk_2, nk_3, na00, na01, na10, na11, nvv, nsc);
                v4u sb0, sb1; sb0.x = pk2c(S0.x, S0.y); sb0.y = pk2c(S0.z, S0.w); sb0.z = pk2c(S1.x, S1.y); sb0.w = pk2c(S1.z, S1.w);
                sb1.x = pk2c(S2.x, S2.y); sb1.y = pk2c(S2.z, S2.w); sb1.z = pk2c(S3.x, S3.y); sb1.w = pk2c(S3.z, S3.w);
                const v4u af0 = (v4u){a00.x, a00.y, a01.x, a01.y}, af1 = (v4u){a10.x, a10.y, a11.x, a11.y};
                f32x4 d = __builtin_amdgcn_mfma_f32_16x16x32_bf16(__builtin_bit_cast(bf16x8, af0), __builtin_bit_cast(bf16x8, sb0), (f32x4){0.f, 0.f, 0.f, 0.f}, 0, 0, 0);
                d = __builtin_amdgcn_mfma_f32_16x16x32_bf16(__builtin_bit_cast(bf16x8, af1), __builtin_bit_cast(bf16x8, sb1), d, 0, 0, 0);
                const float sa = d.x; const float y = d.y + sa * sc.x + vv * sc.y;
                const bf16x8 bu = __builtin_bit_cast(bf16x8, (v4u){pk2c(sa, vv) & m0, 0u, 0u, 0u});
                S0 = __builtin_amdgcn_mfma_f32_16x16x32_bf16(__builtin_bit_cast(bf16x8, (v4u){k_0 & m0, 0u, 0u, 0u}), bu, S0 * w_0, 0, 0, 0);
                S1 = __builtin_amdgcn_mfma_f32_16x16x32_bf16(__builtin_bit_cast(bf16x8, (v4u){k_1 & m0, 0u, 0u, 0u}), bu, S1 * w_1, 0, 0, 0);
                S2 = __builtin_amdgcn_mfma_f32_16x16x32_bf16(__builtin_bit_cast(bf16x8, (v4u){k_2 & m0, 0u, 0u, 0u}), bu, S2 * w_2, 0, 0, 0);
                S3 = __builtin_amdgcn_mfma_f32_16x16x32_bf16(__builtin_bit_cast(bf16x8, (v4u){k_3 & m0, 0u, 0u, 0u}), bu, S3 * w_3, 0, 0, 0);
                if (fq == 0) Yb[t * 64] = y;
                w_0 = nw_0; w_1 = nw_1; w_2 = nw_2; w_3 = nw_3; k_0 = nk_0; k_1 = nk_1; k_2 = nk_2; k_3 = nk_3; a00 = na00; a01 = na01; a10 = na10; a11 = na11; vv = nvv; sc = nsc;
            }
#undef RW_LD
            __syncthreads();
        }
        float* so = C.out + (sample ? O_WKVS : O_WKVP) + ((((size_t)l * 8 + b) * 16 + h) * 64 + row) * 64 + 4 * fq;
        *(f32x4*)so = S0; *(f32x4*)(so + 16) = S1; *(f32x4*)(so + 32) = S2; *(f32x4*)(so + 48) = S3;
    } else {
        const int pw = w - 4, tl = lane >> 4, sub = lane & 15, ch0 = 4 * sub, fr = lane & 15, fq = lane >> 4;
        LAS bf16* XLw = (LAS bf16*)(L + RW_XL + pw * 2176);
        LAS float* ZR = (LAS float*)(L + RW_ZR + pw * 3072);
        LAS bf16* LW0 = (LAS bf16*)(L + RW_LW); LAS bf16* LW1 = LW0 + 64 * 72; LAS bf16* LW2 = LW1 + 64 * 72;
        { const int pt = pw * 64 + lane;
          for (int i = pt; i < 64 * 8; i += 256) { const int n = i >> 3, kc = i & 7;
              *(LAS v4u*)(LW0 + n * 72 + kc * 8) = *(const v4u*)((const bf16*)(C.ws + WS_W2T) + (size_t)(h * 64 + n) * 64 + kc * 8);
              *(LAS v4u*)(LW1 + n * 72 + kc * 8) = *(const v4u*)((const bf16*)(C.ws + WS_A2T) + (size_t)(h * 64 + n) * 64 + kc * 8); }
          for (int i = pt; i < 64 * 16; i += 256) { const int n = i >> 4, kc = i & 15;
              *(LAS v4u*)(LW2 + n * 136 + kc * 8) = *(const v4u*)((const bf16*)(C.ws + WS_G2T) + (size_t)(h * 64 + n) * 128 + kc * 8); } }
        const int gc = h * 64 + ch0;
        const f32x4 cw0 = *(const f32x4*)(C.in[14] + (size_t)l * DM + gc), ca0 = *(const f32x4*)(C.in[16] + (size_t)l * DM + gc), ckk = *(const f32x4*)(C.in[19] + (size_t)l * DM + gc),
                    cka = *(const f32x4*)(C.in[20] + (size_t)l * DM + gc), crk = *(const f32x4*)(C.in[21] + (size_t)l * DM + gc), clg = *(const f32x4*)(C.in[22] + (size_t)l * DM + gc),
                    clb = *(const f32x4*)(C.in[23] + (size_t)l * DM + gc);
        LAS float* MU = (LAS float*)(L + RW_MU);
        { const float* mu = C.in[13] + (size_t)l * RC; const int pt = pw * 64 + lane;
          for (int i = pt; i < 448; i += 256) { const int q = i >> 3, e = i & 7; const int col = q < 8 ? h * 64 + q * 8 : q < 16 ? 1024 + h * 64 + (q - 8) * 8 : q < 24 ? 2048 + h * 64 + (q - 16) * 8 : 3072 + (q - 24) * 8; MU[i] = mu[col + e]; MU[448 + i] = sample ? C.in[5][((size_t)l * 8 + b) * RC + col + e] : 0.f; } }
        RawRegs rA, rB;
        const bf16* PRu = PR + rowbase * RC;
        int ioff[4], itl[4], iq[4];
        { itl[0] = lane / 24; iq[0] = lane % 24;
          if (lane < 32) { itl[1] = (64 + lane) / 24; iq[1] = (64 + lane) % 24; } else { itl[1] = (lane - 32) >> 3; iq[1] = 32 + ((lane - 32) & 7); }
          itl[2] = (lane & 31) >> 3; iq[2] = 24 + (lane & 7);
          itl[3] = lane >> 4; iq[3] = 40 + (lane & 15);
#pragma unroll
          for (int j = 0; j < 4; ++j) { const int q = iq[j]; const int col = q < 8 ? h * 64 + q * 8 : q < 16 ? 1024 + h * 64 + (q - 8) * 8 : q < 24 ? 2048 + h * 64 + (q - 16) * 8 : 3072 + (q - 24) * 8;
              ioff[j] = (4 * pw + itl[j]) * RC + col; } }
        rw_issue(rA, PRu, T, 0, pw, ioff, itl);
        __syncthreads();
#define RW_BODY(c, rcur, FIRST) do { \
            if ((c) >= 1) { const int cp = (c) - 1, tok = 4 * pw + tl; \
                const f32x4 y = *(const LAS f32x4*)(L + RW_YC + (cp & 1) * 4096 + (tok * 64 + ch0) * 4); \
                const LAS unsigned char* Pb = L + RW_POST + (cp % 3) * 8320; \
                const f32x4 g = *(const LAS f32x4*)(Pb + (tok * 64 + ch0) * 4), v = *(const LAS f32x4*)(Pb + 4096 + (tok * 64 + ch0) * 4); const float bon = *(const LAS float*)(Pb + 8192 + tok * 4); \
                const float mean = row16_sum((y.x + y.y) + (y.z + y.w)) * (1.f / 64.f); const f32x4 d = y - mean; \
                const float var = row16_sum((d.x * d.x + d.y * d.y) + (d.z * d.z + d.w * d.w)) * (1.f / 64.f); const float rstd = __builtin_amdgcn_rsqf(var + 64e-5f); \
                const f32x4 o = (d * rstd * clg + clb + v * bon) * g; \
                v2u ow; ow.x = pk2(o.x, o.y); ow.y = pk2(o.z, o.w); \
                *(v2u*)(Yg + (rowbase + cp * 16 + tok) * DM + gc) = ow; } \
            const int cn = (c) + 1; \
            if (cn < NC) { \
                LAS float* Mb = (LAS float*)(L + RW_MAIN + (cn & 1) * RW_MSTR); LAS float* Pf = (LAS float*)(L + RW_POST + (cn % 3) * 8320); \
_Pragma("unroll") \
                for (int j = 0; j < 4; ++j) { const int t4 = itl[j], q = iq[j]; const int t = cn * 16 + 4 * pw + t4; \
                    { const int col = q < 8 ? h * 64 + q * 8 : q < 16 ? 1024 + h * 64 + (q - 8) * 8 : q < 24 ? 2048 + h * 64 + (q - 16) * 8 : 3072 + (q - 24) * 8; \
                        float cur[8], prv[8]; unpack8(rcur.cur[j], cur); unpack8(rcur.prv[j], prv); \
                        if (FIRST && t == 0) { const f32x4 x0 = *(const LAS f32x4*)(MU + 448 + q * 8), x1 = *(const LAS f32x4*)(MU + 452 + q * 8); \
                            prv[0] = x0.x; prv[1] = x0.y; prv[2] = x0.z; prv[3] = x0.w; prv[4] = x1.x; prv[5] = x1.y; prv[6] = x1.z; prv[7] = x1.w; } \
                        const f32x4 m0 = *(const LAS f32x4*)(MU + q * 8), m1 = *(const LAS f32x4*)(MU + q * 8 + 4); \
                        const float mm[8] = {m0.x, m0.y, m0.z, m0.w, m1.x, m1.y, m1.z, m1.w}; float mx[8]; \
_Pragma("unroll") \
                        for (int e = 0; e < 8; ++e) mx[e] = cur[e] + (prv[e] - cur[e]) * mm[e]; \
                        const int tok = 4 * pw + t4; \
                        if (q < 24) { LAS float* dst = (q < 8 ? Mb : q < 16 ? Mb + 1024 : Pf + 1024) + tok * 64 + (q & 7) * 8; \
                            *(LAS f32x4*)dst = (f32x4){mx[0], mx[1], mx[2], mx[3]}; *(LAS f32x4*)(dst + 4) = (f32x4){mx[4], mx[5], mx[6], mx[7]}; } \
                        else { float o[8]; \
                            if (q < 32) { \
_Pragma("unroll") \
                                for (int e = 0; e < 8; ++e) { const float ex = __expf(2.0f * mx[e]); o[e] = 1.0f - 2.0f * __builtin_amdgcn_rcpf(ex + 1.0f); } } \
                            else if (q < 40) { \
_Pragma("unroll") \
                                for (int e = 0; e < 8; ++e) o[e] = mx[e]; } \
                            else { \
_Pragma("unroll") \
                                for (int e = 0; e < 8; ++e) o[e] = pg8::fast_sigmoid(mx[e]); } \
                            *(LAS v4u*)(XLw + t4 * 264 + (q - 24) * 8) = pack8(o); } } } \
                asm volatile("" ::: "memory"); \
_Pragma("unroll") \
                for (int mat = 0; mat < 3; ++mat) { const int KK = mat == 2 ? 128 : 64, xoff = mat * 64, st = mat == 2 ? 136 : 72; const LAS bf16* LWm = mat == 0 ? LW0 : mat == 1 ? LW1 : LW2; \
_Pragma("unroll") \
                    for (int nt = 0; nt < 4; ++nt) { f32x4 acc = (f32x4){0.f, 0.f, 0.f, 0.f}; \
_Pragma("unroll") \
                        for (int k2 = 0; k2 < KK / 32; ++k2) { const bf16x8 wf = *(const LAS bf16x8*)(LWm + (nt * 16 + fr) * st + k2 * 32 + fq * 8); \
                            const bf16x8 xf = *(const LAS bf16x8*)(XLw + (fr & 3) * 264 + xoff + k2 * 32 + fq * 8); \
                            acc = __builtin_amdgcn_mfma_f32_16x16x32_bf16(wf, xf, acc, 0, 0, 0); } \
                        if (fr < 4) *(LAS f32x4*)(ZR + mat * 256 + fr * 64 + nt * 16 + 4 * fq) = acc; } } \
                asm volatile("" ::: "memory"); \
                { const int tok = 4 * pw + tl; \
                  const f32x4 z = *(const LAS f32x4*)(ZR + tl * 64 + ch0), ar = *(const LAS f32x4*)(ZR + 256 + tl * 64 + ch0), g = *(const LAS f32x4*)(ZR + 512 + tl * 64 + ch0); \
                  const f32x4 k = *(const LAS f32x4*)(Mb + 1024 + tok * 64 + ch0), r = *(const LAS f32x4*)(Mb + tok * 64 + ch0); \
                  f32x4 wd, a; \
_Pragma("unroll") \
                  for (int e = 0; e < 4; ++e) { wd[e] = __expf(-0.60653066f * pg8::fast_sigmoid(cw0[e] + z[e])); a[e] = pg8::fast_sigmoid(ca0[e] + ar[e]); } \
                  const f32x4 kk = k * ckk; const float ss = row16_sum((kk.x * kk.x + kk.y * kk.y) + (kk.z * kk.z + kk.w * kk.w)); \
                  const float inv = __builtin_amdgcn_rsqf(fmaxf(ss, 1e-24f)); const f32x4 kn = kk * inv; const f32x4 kp = k * (1.0f + (a - 1.0f) * cka); \
                  const f32x4 rb = r * kp * crk; const float bon = row16_sum((rb.x + rb.y) + (rb.z + rb.w)); \
                  const f32x4 bq = kn * a; const f32x4 t1 = bq * r, t2 = kp * r; const float br = row16_sum((t1.x + t1.y) + (t1.z + t1.w)), kr = row16_sum((t2.x + t2.y) + (t2.z + t2.w)); *(LAS f32x4*)(Mb + tok * 64 + ch0) = wd * r; if (sub == 0) *(LAS f32x2*)(Mb + 5120 + tok * 2) = (f32x2){br, kr}; *(LAS f32x4*)(Mb + 2048 + tok * 64 + ch0) = wd; { const f32x4 wr_ = wd * r; LAS bf16* ab = (LAS bf16*)(Mb + 3072); v2u pa, pq; pa.x = pk2(-kn.x, -kn.y); pa.y = pk2(-kn.z, -kn.w); pq.x = pk2(wr_.x, wr_.y); pq.y = pk2(wr_.z, wr_.w); *(LAS v2u*)(ab + tok * 64 + ch0) = pa; *(LAS v2u*)(ab + 1024 + tok * 64 + ch0) = pq; } *(LAS v4u*)((LAS unsigned*)(Mb + 4096) + tok * 64 + ch0) = (v4u){pk2(bq.x, kp.x), pk2(bq.y, kp.y), pk2(bq.z, kp.z), pk2(bq.w, kp.w)}; \
                  *(LAS f32x4*)(Pf + tok * 64 + ch0) = g; if (sub == 0) Pf[2048 + tok] = bon; } \
            } \
        } while (0)
        rw_issue(rB, PRu, T, 1, pw, ioff, itl);
        RW_BODY(-1, rA, true);
        __syncthreads();
        for (int c2 = 0; c2 < NC; c2 += 2) {
            if (!sample && c2 == 142) {
                if (lane == 0) { unsigned sp = 0; while (__hip_atomic_load((const unsigned*)C.ws + 32, __ATOMIC_RELAXED, __HIP_MEMORY_SCOPE_AGENT) < 128u * (unsigned)(l + 1) && ++sp < (1u << 24)) __builtin_amdgcn_s_sleep(4); }
                __builtin_amdgcn_fence(__ATOMIC_ACQUIRE, "agent"); asm volatile("s_waitcnt vmcnt(0)" ::: "memory"); }
            rw_issue(rA, PRu, T, c2 + 2, pw, ioff, itl);
            RW_BODY(c2, rB, false);
            __syncthreads();
            rw_issue(rB, PRu, T, c2 + 3, pw, ioff, itl);
            RW_BODY(c2 + 1, rA, false);
            __syncthreads();
        }
#undef RW_BODY
        { const int cp = NC - 1, tok = 4 * pw + tl;
          const f32x4 y = *(const LAS f32x4*)(L + RW_YC + (cp & 1) * 4096 + (tok * 64 + ch0) * 4);
          const LAS unsigned char* Pb = L + RW_POST + (cp % 3) * 8320;
          const f32x4 g = *(const LAS f32x4*)(Pb + (tok * 64 + ch0) * 4), v = *(const LAS f32x4*)(Pb + 4096 + (tok * 64 + ch0) * 4); const float bon = *(const LAS float*)(Pb + 8192 + tok * 4);
          const float mean = row16_sum((y.x + y.y) + (y.z + y.w)) * (1.f / 64.f); const f32x4 d = y - mean;
          const float var = row16_sum((d.x * d.x + d.y * d.y) + (d.z * d.z + d.w * d.w)) * (1.f / 64.f); const float rstd = __builtin_amdgcn_rsqf(var + 64e-5f);
          const f32x4 o = (d * rstd * clg + clb + v * bon) * g;
          v2u ow; ow.x = pk2(o.x, o.y); ow.y = pk2(o.z, o.w);
          *(v2u*)(Yg + (rowbase + cp * 16 + tok) * DM + gc) = ow; }
    }
    __syncthreads();
}
__device__ __forceinline__ void rwkv_phase(const Ctx& C, int l, bool aux, int csub) {
    { const int s = aux ? 1 : 0, r = csub & 127;
      Ctx C2 = C; { int t_ = C.tid; asm volatile("" : "+v"(t_)); C2.tid = t_; C2.lane = t_ & 63; C2.wave = __builtin_amdgcn_readfirstlane(t_ >> 6); }
      rwkv_unit(C2, l, s, r >> 4, r & 15); }
    if (!aux) { const bf16* PR = (const bf16*)(C.ws + WS_BIG);
      for (int i = blockIdx.x * NT + C.tid; i < 16 * RC; i += 128 * NT) { const int bb = i / RC, c = i % RC;
        const size_t row = bb < 8 ? (size_t)bb * SEQ + SEQ - 1 : (size_t)MP + (size_t)(bb - 8) * DECS + DECS - 1;
        const float v = __uint_as_float((unsigned)PR[row * RC + c] << 16);
        C.out[(bb < 8 ? O_SHP : O_SHS) + ((size_t)l * 8 + (bb & 7)) * RC + c] = v; } }
}

__device__ __forceinline__ void sgu_phase(const Ctx& C, int l, int csub, int gsub) {
    const bf16* UV = (const bf16*)(C.ws + WS_UVB); bf16* Yg = (bf16*)(C.ws + WS_UVB); const bf16* WS = (const bf16*)(C.ws + WS_WS);
    const float* lng = C.in[24] + (size_t)l * DM; const float* lnb = C.in[25] + (size_t)l * DM; const float* bs = C.in[27] + (size_t)l * 8 * 128;
    LAS float* stat = (LAS float*)C.lds;
    const int lane = C.lane, w = C.wave, fr = lane & 15, fq = lane >> 4;
    LAS bf16* VT = (LAS bf16*)(C.lds + 1024 + w * 8704);
    for (int u = csub; u < 520; u += gsub) {
        const int sample = u >= 512; const int nrows = sample ? 32 : 128;
        const size_t row0 = sample ? (size_t)MP + (size_t)(u - 512) * DECS : (size_t)u * 128;
        for (int tk = w * 16; tk < w * 16 + 16; ++tk) {
            if (tk < nrows) {
                const bf16* vp = UV + (row0 + tk) * 2048 + 1024 + lane * 16; float x[16];
                unpack8(*(const v4u*)vp, x); unpack8(*(const v4u*)(vp + 8), x + 8);
                float s = 0.f;
#pragma unroll
                for (int e = 0; e < 16; ++e) s += x[e];
                const float mean = wave_sum(s) * (1.f / 1024.f); float q = 0.f;
#pragma unroll
                for (int e = 0; e < 16; ++e) { x[e] -= mean; q += x[e] * x[e]; }
                const float rstd = 1.0f / sqrtf(wave_sum(q) * (1.f / 1024.f) + 1e-5f);
                if (lane == 0) { stat[tk * 2] = mean; stat[tk * 2 + 1] = rstd; }
                if (sample) { float* op = C.out + O_SGUV + (((size_t)l * 8 + (u - 512)) * DECS + tk) * DM + lane * 16;
#pragma unroll
                    for (int e4 = 0; e4 < 4; ++e4) { const f32x4 gg = *(const f32x4*)(lng + lane * 16 + e4 * 4), bb = *(const f32x4*)(lnb + lane * 16 + e4 * 4);
                        f32x4 o; o.x = x[e4 * 4] * rstd * gg.x + bb.x; o.y = x[e4 * 4 + 1] * rstd * gg.y + bb.y; o.z = x[e4 * 4 + 2] * rstd * gg.z + bb.z; o.w = x[e4 * 4 + 3] * rstd * gg.w + bb.w;
                        *(f32x4*)(op + e4 * 4) = o; } }
            }
        }
        __syncthreads();
        const int g = w;
        for (int q4 = 0; q4 < 4; ++q4) {
            const int c0 = g * 128 + q4 * 32;
            { const int cl = lane & 3, jl = lane >> 2; float gg[8], bb[8];
#pragma unroll
              for (int e = 0; e < 8; ++e) { gg[e] = lng[c0 + cl * 8 + e]; bb[e] = lnb[c0 + cl * 8 + e]; }
#pragma unroll
              for (int p = 0; p < 8; ++p) { const int j = p * 16 + jl; float x[8];
                  if (j < nrows) { unpack8(*(const v4u*)(UV + (row0 + j) * 2048 + 1024 + c0 + cl * 8), x); const float mean = stat[j * 2], rstd = stat[j * 2 + 1];
#pragma unroll
                      for (int e = 0; e < 8; ++e) x[e] = (x[e] - mean) * rstd * gg[e] + bb[e]; }
                  else {
#pragma unroll
                      for (int e = 0; e < 8; ++e) x[e] = 0.f; }
#pragma unroll
                  for (int e = 0; e < 8; ++e) VT[(cl * 8 + e) * 136 + j] = (bf16)f2bf(x[e]); } }
            LDS_WAIT(); __builtin_amdgcn_wave_barrier();
            const int nit = nrows / 16;
            for (int it = 0; it < nit; ++it) {
                f32x4 acc0 = (f32x4){0.f, 0.f, 0.f, 0.f}, acc1 = acc0;
                for (int k2 = 0; k2 <= (it >> 1); ++k2) {
                    const bf16x8 wf = *(const bf16x8*)(WS + ((size_t)g * 128 + it * 16 + fr) * 128 + k2 * 32 + fq * 8);
                    const bf16x8 v0 = *(const LAS bf16x8*)(VT + (fr) * 136 + k2 * 32 + fq * 8);
                    const bf16x8 v1 = *(const LAS bf16x8*)(VT + (16 + fr) * 136 + k2 * 32 + fq * 8);
                    acc0 = __builtin_amdgcn_mfma_f32_16x16x32_bf16(v0, wf, acc0, 0, 0, 0);
                    acc1 = __builtin_amdgcn_mfma_f32_16x16x32_bf16(v1, wf, acc1, 0, 0, 0);
                }
                const int i = it * 16 + fr; const float bsi = bs[g * 128 + i];
#pragma unroll
                for (int ct = 0; ct < 2; ++ct) { const f32x4 a = ct ? acc1 : acc0; const int c = c0 + ct * 16 + fq * 4;
                    const v2u uu = *(const v2u*)(UV + (row0 + i) * 2048 + c);
                    v2u o; o.x = pk2(bflo(uu.x) * (a.x + bsi), bfhi(uu.x) * (a.y + bsi)); o.y = pk2(bflo(uu.y) * (a.z + bsi), bfhi(uu.y) * (a.w + bsi));
                    *(v2u*)(Yg + (row0 + i) * 2048 + c) = o; }
            }
            LDS_WAIT(); __builtin_amdgcn_wave_barrier();
        }
        __syncthreads();
    }
}

__device__ __forceinline__ void attn_phase(const Ctx& C, int csub, int gsub) {
    const bf16* Q = (const bf16*)(C.ws + WS_UVB) + 1024; bf16* Yg = (bf16*)(C.ws + WS_UVB) + 1024;
    const bf16* KB = (const bf16*)(C.ws + WS_KB); const bf16* VT = (const bf16*)(C.ws + WS_VT);
    const int lane = C.lane, w = C.wave, fr = lane & 15, fq = lane >> 4, tid = C.tid;
    LAS bf16* KL = (LAS bf16*)C.lds;
    for (int u = csub; u < 1024 + 32; u += gsub) {
        int bb, h, nqt; size_t rowq;
        if (u < 1024) { const int rb = u >> 2; h = u & 3; bb = rb >> 5; rowq = (size_t)rb * 256 + w * 32; nqt = 2; }
        else { const int su = u - 1024; h = su & 3; bb = 8 + (su >> 2); rowq = (size_t)MP + (size_t)(su >> 2) * DECS + w * 16; nqt = w < 2 ? 1 : 0; }
        const bf16* Kp = KB + (size_t)bb * 262144 + h * 256; const bf16* Vp = VT + ((size_t)bb * 4 + h) * 65536;
        __syncthreads();
#pragma unroll 4
        for (int i = tid; i < 8192; i += NT) { const int m = i >> 5, ch = i & 31; *(LAS v4u*)(KL + m * 264 + ch * 8) = *(const v4u*)(Kp + (size_t)m * 1024 + ch * 8); }
        __syncthreads();
        bf16x8 pf[2][8]; float rs[2];
#pragma unroll
        for (int j = 0; j < 2; ++j) {
            rs[j] = 0.f;
#pragma unroll
            for (int k2 = 0; k2 < 8; ++k2) pf[j][k2] = (bf16x8){0, 0, 0, 0, 0, 0, 0, 0};
            if (j < nqt) {
                const size_t row0 = rowq + j * 16;
                bf16x8 qf[8];
#pragma unroll
                for (int k2 = 0; k2 < 8; ++k2) qf[k2] = *(const bf16x8*)(Q + (row0 + fr) * 2048 + h * 256 + k2 * 32 + fq * 8);
                f32x4 s[16];
#pragma unroll
                for (int mt = 0; mt < 16; ++mt) { f32x4 acc = (f32x4){0.f, 0.f, 0.f, 0.f};
#pragma unroll
                    for (int k2 = 0; k2 < 8; ++k2) { const bf16x8 kf = *(const LAS bf16x8*)(KL + (mt * 16 + fr) * 264 + k2 * 32 + fq * 8);
                        acc = __builtin_amdgcn_mfma_f32_16x16x32_bf16(kf, qf[k2], acc, 0, 0, 0); }
                    s[mt] = acc; }
                float mx = -3.0e38f;
#pragma unroll
                for (int mt = 0; mt < 16; ++mt) mx = fmaxf(mx, fmaxf(fmaxf(s[mt].x, s[mt].y), fmaxf(s[mt].z, s[mt].w)));
                mx = fmaxf(mx, __shfl_xor(mx, 16)); mx = fmaxf(mx, __shfl_xor(mx, 32));
                float sum = 0.f;
#pragma unroll
                for (int mt = 0; mt < 16; ++mt) {
#pragma unroll
                    for (int e = 0; e < 4; ++e) { const float p = __expf((s[mt][e] - mx) * 0.0625f); s[mt][e] = p; sum += p; } }
                sum += __shfl_xor(sum, 16); sum += __shfl_xor(sum, 32);
                rs[j] = 1.0f / sum;
#pragma unroll
                for (int k2 = 0; k2 < 8; ++k2) { v4u pw; pw.x = pk2(s[2 * k2].x, s[2 * k2].y); pw.y = pk2(s[2 * k2].z, s[2 * k2].w); pw.z = pk2(s[2 * k2 + 1].x, s[2 * k2 + 1].y); pw.w = pk2(s[2 * k2 + 1].z, s[2 * k2 + 1].w);
                    pf[j][k2] = __builtin_bit_cast(bf16x8, pw); }
            }
        }
        __syncthreads();
#pragma unroll 4
        for (int i = tid; i < 8192; i += NT) { const int d = i >> 5, ch = i & 31; *(LAS v4u*)(KL + d * 264 + ch * 8) = *(const v4u*)(Vp + (size_t)d * 256 + ch * 8); }
        __syncthreads();
#pragma unroll
        for (int j = 0; j < 2; ++j) {
            if (j < nqt) {
                const size_t row0 = rowq + j * 16;
#pragma unroll 2
                for (int dt = 0; dt < 16; ++dt) { f32x4 acc = (f32x4){0.f, 0.f, 0.f, 0.f};
#pragma unroll
                    for (int k2 = 0; k2 < 8; ++k2) { const bf16x8 vf = *(const LAS bf16x8*)(KL + (dt * 16 + fr) * 264 + k2 * 32 + fq * 8);
                        acc = __builtin_amdgcn_mfma_f32_16x16x32_bf16(vf, pf[j][k2], acc, 0, 0, 0); }
                    v2u o; o.x = pk2(acc.x * rs[j], acc.y * rs[j]); o.y = pk2(acc.z * rs[j], acc.w * rs[j]);
                    *(v2u*)(Yg + (row0 + fr) * 2048 + h * 256 + dt * 16 + fq * 4) = o; }
            }
        }
    }
    __syncthreads();
}

__device__ __forceinline__ void final_norm(const Ctx& C) {
    float* X = C.out; const float* g = C.in[10];
    for (int r = C.gw; r < M; r += C.ngw) {
        f32x4* xr = (f32x4*)(X + (size_t)r * DM) + C.lane; const f32x4* gr = (const f32x4*)g + C.lane;
        f32x4 v[4]; float s = 0.f;
#pragma unroll
        for (int j = 0; j < 4; ++j) { v[j] = xr[64 * j]; s += (v[j].x * v[j].x + v[j].y * v[j].y) + (v[j].z * v[j].z + v[j].w * v[j].w); }
        const float rr = 1.0f / sqrtf(wave_sum(s) * (1.f / DM) + 1e-6f);
#pragma unroll
        for (int j = 0; j < 4; ++j) xr[64 * j] = v[j] * rr * gr[64 * j];
    }
}

__device__ __forceinline__ void small_gemm(const Ctx& C, int csub, int gsub, const bf16* A, int lda, const bf16* Bt, int N, int K, int mode, bf16* O, const bf16* T, float* X, int ldc, int first) {
    const int lane = C.lane, w = C.wave, fr = lane & 15, fq = lane >> 4;
    const int nit = 8 * (N >> 6);
    for (int it = csub; it < nit; it += gsub) {
        const int rg = it & 7, cg = it >> 3;
        const size_t row = (size_t)MP + rg * 32 + (w & 1) * 16 + fr; const int colb = cg * 64 + (w >> 1) * 16;
        const bf16* ap = A + row * lda + fq * 8; const bf16* bp = Bt + (size_t)(colb + fr) * K + fq * 8;
        f32x4 acc = (f32x4){0.f, 0.f, 0.f, 0.f};
#pragma unroll 16
        for (int k2 = 0; k2 < (K >> 5); ++k2) { const bf16x8 af = *(const bf16x8*)(ap + k2 * 32), bf = *(const bf16x8*)(bp + k2 * 32);
            acc = __builtin_amdgcn_mfma_f32_16x16x32_bf16(bf, af, acc, 0, 0, 0); }
        const size_t off = row * ldc + colb + 4 * fq;
        if (mode == 4) { f32x4* p = (f32x4*)(X + off); *p = *p + acc; }
        else { f32x4 v = acc;
            if (mode == 1) {
#pragma unroll
                for (int e = 0; e < 4; ++e) v[e] = pg8::gelu_tanh(v[e]); }
            else if (mode == 2) {
#pragma unroll
                for (int e = 0; e < 4; ++e) { const float r = fmaxf(v[e], 0.f); v[e] = r * r; } }
            else if (mode == 3) { const v2u t = *(const v2u*)(T + off); v2u g = (v2u){0u, 0u}; if (!first) g = *(const v2u*)(O + off);
                v[0] = bflo(g.x) + pg8::fast_sigmoid(v[0]) * bflo(t.x); v[1] = bfhi(g.x) + pg8::fast_sigmoid(v[1]) * bfhi(t.x);
                v[2] = bflo(g.y) + pg8::fast_sigmoid(v[2]) * bflo(t.y); v[3] = bfhi(g.y) + pg8::fast_sigmoid(v[3]) * bfhi(t.y); }
            v2u o; o.x = pk2(v[0], v[1]); o.y = pk2(v[2], v[3]); *(v2u*)(O + off) = o; }
    }
}

#ifndef PH_LO
#define PH_LO 0
#endif
#ifndef PH_HI
#define PH_HI 1000
#endif
__global__ void __launch_bounds__(NT, 2) mega_fwd(Args args) {
    extern __shared__ __attribute__((aligned(16))) unsigned char lds_raw[];
    cg::grid_group grid = cg::this_grid();
    const int G = gridDim.x, cb = blockIdx.x;
    typedef pg8::bf16_t pb;
    constexpr int NSTEP = 2 + 16 * DEPTH + 1;
    const bool aux = blockIdx.x >= 128; const int csub = aux ? (int)blockIdx.x - 128 : (int)blockIdx.x;
    unsigned* const subcnt = (unsigned*)args.ws;
    int nbar = 0;
    bool second = false;
    for (int step = PH_LO; step < NSTEP && step < PH_HI; ++step) {
        Ctx C; { int z_ = 0, t_ = threadIdx.x; asm volatile("" : "+s"(z_), "+v"(t_));
                 C.in = args.in + z_; C.out = args.out + z_; C.ws = args.ws + z_; C.lds = (LAS unsigned char*)lds_raw; C.tid = t_; C.lane = t_ & 63; C.wave = __builtin_amdgcn_readfirstlane(t_ >> 6);
                 C.gw = blockIdx.x * NWAVES + C.wave; C.ngw = gridDim.x * NWAVES; }
        int l = 0, ls = -1;
        if (step >= 2 && step < 2 + 16 * DEPTH) { l = (step - 2) / 16; ls = (step - 2) % 16; }
        int gm = -1, gN = 0, gK = DM, gM = MP, ldc = 0, lda = DM, first = 0, memkv = 0, gG = G, gc = cb, half = 0; size_t aoff = 0, boff = 0, ooff = 0, toff = 0; bool sync = true;
        if (step == 1) { gm = 5; gM = 8192; gN = 8192; aoff = WS_AMEM; boff = WS_WMKV; memkv = 1; }
        switch (ls) {
            case 1: gm = 0; gN = RC; aoff = WS_H; boff = WS_WIN; ooff = WS_BIG; ldc = RC; gM = 8 * 9 * 256; half = 1; break;
            case 2: if (aux) { gG = 128; gc = csub;
                        if (!second) { gm = 0; gN = RC; aoff = WS_H; boff = WS_WIN; ooff = WS_BIG; ldc = RC; gM = 8 * 23 * 256; half = 2; }
                        else { gm = 1; gN = 2048; aoff = WS_H; boff = WS_WIN + (size_t)COL_GMLP * DM * 2; ooff = WS_UVB; ldc = 2048; } } sync = false; break;
            case 3: sync = false; break;
            case 4: if (aux) { gm = 0; gN = DM; aoff = WS_H; boff = WS_WIN + (size_t)COL_Q * DM * 2; ooff = WS_UVB + 2048; ldc = 2048; gG = 128; gc = csub; } sync = false; break;
            case 6: gm = 0; gN = DM; aoff = WS_Y; boff = WS_WB; ooff = WS_T2; ldc = DM; sync = false; break;
            case 7: gm = 3; gN = DM; aoff = WS_H; boff = WS_WIN + (size_t)COL_GATE * DM * 2; ooff = WS_MG2; toff = WS_T2; ldc = DM; first = 1; sync = false; break;
            case 8: gm = 0; gN = DM; aoff = WS_UVB; lda = 2048; boff = WS_WB + (size_t)DM * DM * 2; ooff = WS_T2; ldc = DM; sync = false; break;
            case 9: gm = 3; gN = DM; aoff = WS_H; boff = WS_WIN + (size_t)(COL_GATE + DM) * DM * 2; ooff = WS_MG2; toff = WS_T2; ldc = DM; sync = false; break;
            case 10: gm = 0; gN = DM; aoff = WS_UVB + 2048; lda = 2048; boff = WS_WB + 2 * (size_t)DM * DM * 2; ooff = WS_T2; ldc = DM; sync = false; break;
            case 11: gm = 3; gN = DM; aoff = WS_H; boff = WS_WIN + (size_t)(COL_GATE + 2 * DM) * DM * 2; ooff = WS_MG2; toff = WS_T2; ldc = DM; break;
            case 12: gm = 4; gN = DM; aoff = WS_MG2; boff = WS_WOUT; ldc = DM; break;
            case 14: gm = 2; gN = DFF; aoff = WS_H; boff = WS_WUP; ooff = WS_UP; ldc = DFF; break;
            case 15: gm = 4; gN = DM; gK = DFF; lda = DFF; aoff = WS_UP; boff = WS_WDN; ldc = DM; break;
            default: break;
        }
        if (gm >= 0) {
            pg8::Gemm g_{(const pb*)(C.ws + aoff), (const pb*)(C.ws + boff), gM, gN, gK, lda};
            pg8::OrderU S_; S_.so.init(gM, gN, gG, gc); S_.memkv = memkv; S_.half = half;
            pg8::EpiU E_{gm, gm <= 3, (pb*)(C.ws + ooff), (const pb*)(C.ws + toff), gm == 5 ? C.out + O_MK : C.out, C.out + O_MV, ldc, first};
            pg8::gemm_phase<pg8::EpiU, pg8::OrderU, true, true>(C.lds, g_, S_, E_);
            if (half == 2) {
                asm volatile("s_waitcnt vmcnt(0)" ::: "memory"); __syncthreads();
                if (threadIdx.x == 0) { __builtin_amdgcn_fence(__ATOMIC_RELEASE, "agent"); asm volatile("s_waitcnt vmcnt(0)" ::: "memory"); __hip_atomic_fetch_add(subcnt + 32, 1u, __ATOMIC_RELAXED, __HIP_MEMORY_SCOPE_AGENT); }
            } else if (!memkv) small_gemm(C, gc, gG, (const bf16*)(C.ws + aoff), lda, (const bf16*)(C.ws + boff), gN, gK, gm, (bf16*)(C.ws + ooff), (const bf16*)(C.ws + toff), C.out, ldc, first);
        }
        else if (step == 0 || ls == 0 || ls == 13) prep_phase(C, step == 0 ? -1 : ls == 0 ? l : -2, l);
        else if (step == NSTEP - 1) { final_norm(C); sync = false; }
        else if ((ls == 2 && !aux) || (ls == 3 && aux)) { rwkv_phase(C, l, aux, csub); if (aux) sgu_phase(C, l, csub, 128); }
        else if (ls == 5 && aux) attn_phase(C, csub, 128);
        if (aux && ls == 2 && !second) { second = true; --step; continue; }
        second = false;
        if (aux && ls >= 2 && ls <= 4) sub_barrier(subcnt, 128u * (unsigned)(l * 3 + (ls - 1)));
        if (sync) { if (step == 0) grid.sync();
                    else sub_barrier(subcnt + 64, (unsigned)G * (unsigned)(++nbar)); }
    }
}

extern "C" void kernel_launch(void* const* d_in, const int* in_sizes, int n_in, void* d_out, int out_size, void* d_ws, size_t ws_size, hipStream_t stream) {
    static int grid = 0;
    if (grid == 0) {
        if (n_in != 32 || (size_t)out_size != O_END || ws_size < WS_END) { fprintf(stderr, "kernel_launch: unexpected shapes n_in %d out %d ws %zu (need %zu)\n", n_in, out_size, ws_size, (size_t)WS_END); grid = -1; return; }
        int dev = 0, cus = 0, per_cu = 0;
        hipGetDevice(&dev); hipDeviceGetAttribute(&cus, hipDeviceAttributeMultiprocessorCount, dev);
        hipFuncSetAttribute((const void*)mega_fwd, hipFuncAttributeMaxDynamicSharedMemorySize, LDS_BYTES);
        hipOccupancyMaxActiveBlocksPerMultiprocessor(&per_cu, (const void*)mega_fwd, NT, LDS_BYTES);
        (void)hipGetLastError();
        if (per_cu < 1) per_cu = 1;
        grid = 256;
        if (cus < 256) { fprintf(stderr, "kernel_launch: needs 256 CUs, device has %d\n", cus); grid = -1; return; }
    }
    if (grid < 0) return;
    (void)hipMemsetAsync(d_ws, 0, 512, stream);
    Args a{};
    for (int i = 0; i < 32; ++i) a.in[i] = (const float*)d_in[i];
    a.out = (float*)d_out; a.ws = (unsigned char*)d_ws;
    void* params[] = {&a};
    hipError_t e = hipLaunchCooperativeKernel((const void*)mega_fwd, dim3(grid), dim3(NT), params, LDS_BYTES, stream);
    if (e != hipSuccess) fprintf(stderr, "cooperative launch failed: %s (grid %d)\n", hipGetErrorString(e), grid);
}
```
